# Optimizing an MI355X kernel written in HIP

```python
import math
import jax
import jax.numpy as jnp
from jax import lax
import numpy as np


D_MODEL = 1024
BATCH = 8
SEQ = 2048
DEPTH = 2

CTX_LEN = 256
GRID_W = 64
Q_BLOCK = 128
ROPE_THETA = 10000.0
EPS = 1e-6
NEG_BIG = -1e30

MIX_W = D_MODEL // 2
A_HEAD_DIM = 64
A_HEADS = MIX_W // (2 * A_HEAD_DIM)
B_HEAD_DIM = 64
B_Q_HEADS = MIX_W // B_HEAD_DIM
B_KV_HEADS = 2
C_HEAD_DIM = 128
C_HEADS = MIX_W // C_HEAD_DIM
C_CONV = 3
C_CHUNK = 128
N_BRANCH = 3
IN_WIDTHS = (MIX_W, MIX_W, MIX_W, MIX_W, B_KV_HEADS * B_HEAD_DIM, B_KV_HEADS * B_HEAD_DIM,
             MIX_W, MIX_W, MIX_W, MIX_W, 4 * C_HEADS, N_BRANCH * D_MODEL)
IN_COLS = sum(IN_WIDTHS)
N_EXPERTS = 16
EXPERT_FF = 2 * D_MODEL
EC_CAPACITY_FACTOR = 2

kernel_name = 'hybrid_diffusion_block'


def rmsnorm(x, w):
    xf = x.astype(jnp.float32)
    y = xf * lax.rsqrt(jnp.mean(xf * xf, axis=-1, keepdims=True) + EPS)
    return (y * w.astype(jnp.float32)).astype(x.dtype)


def modulate(x, shift, scale):
    return x * (1.0 + scale) + shift


def split_columns(p):
    return jnp.split(p, np.cumsum(IN_WIDTHS)[:-1].tolist(), axis=-1)


def diff_lambda_init(layer):
    return 0.8 - 0.6 * math.exp(-0.3 * layer)


def axial_rope_tables(n_tokens, head_dim):
    n_rows = n_tokens // GRID_W
    rows = jnp.repeat(jnp.arange(n_rows, dtype=jnp.float32), GRID_W)
    cols = jnp.tile(jnp.arange(GRID_W, dtype=jnp.float32), n_rows)
    n_freq = head_dim // 4
    inv_freq = ROPE_THETA ** (-jnp.arange(n_freq, dtype=jnp.float32) / n_freq)
    ang = jnp.concatenate([rows[:, None] * inv_freq, cols[:, None] * inv_freq], axis=-1)
    return jnp.cos(ang), jnp.sin(ang)


def apply_rope(x, cos, sin):
    shape = (1, x.shape[1]) + (1,) * (x.ndim - 3) + (x.shape[-1] // 2,)
    c = cos.reshape(shape).astype(x.dtype)
    s = sin.reshape(shape).astype(x.dtype)
    x1, x2 = jnp.split(x, 2, axis=-1)
    return jnp.concatenate([x1 * c - x2 * s, x1 * s + x2 * c], axis=-1)


def sweep_query_blocks(fn, q):
    B, L = q.shape[:2]
    nb = L // Q_BLOCK
    qb = jnp.moveaxis(q.reshape((B, nb, Q_BLOCK) + q.shape[2:]), 1, 0)
    out = lax.map(fn, qb)
    return jnp.moveaxis(out, 0, 1).reshape((B, L) + out.shape[3:])


def diff_attention(q, k, v, lam, subln_w, lam_init):
    s = jnp.einsum('bqhjd,bkhjd->bhjqk', q, k).astype(jnp.float32) * (A_HEAD_DIM ** -0.5)
    p = jax.nn.softmax(s, axis=-1)
    p = p[:, :, 0] - lam * p[:, :, 1]
    o = jnp.einsum('bhqk,bkhe->bqhe', p.astype(v.dtype), v)
    o = rmsnorm(o, subln_w) * (1.0 - lam_init)
    return o.reshape(o.shape[:2] + (-1,))


def gqa_attention(q, k, v):
    B, Lq = q.shape[:2]
    qg = q.reshape(B, Lq, B_KV_HEADS, B_Q_HEADS // B_KV_HEADS, B_HEAD_DIM)
    s = jnp.einsum('bqhgd,bkhd->bhgqk', qg, k).astype(jnp.float32) * (B_HEAD_DIM ** -0.5)
    p = jax.nn.softmax(s, axis=-1)
    o = jnp.einsum('bhgqk,bkhd->bqhgd', p.astype(v.dtype), v)
    return o.reshape(B, Lq, B_Q_HEADS * B_HEAD_DIM)


def centred_depthwise_conv(x, w):
    K = w.shape[0]
    pad = K // 2
    L = x.shape[1]
    xp = jnp.pad(x, ((0, 0), (pad, pad), (0, 0)))
    return sum(xp[:, j:j + L] * w[j] for j in range(K))


def mlstm_chunkwise(q, k, v, ig, lf, state):
    B, L, H, _ = q.shape
    nc = L // C_CHUNK

    def chunks(a):
        return jnp.moveaxis(a.reshape((B, nc, C_CHUNK) + a.shape[2:]), 1, 0)

    tril = jnp.tril(jnp.ones((C_CHUNK, C_CHUNK), dtype=bool))

    def step(carry, xs):
        C, n, m = carry
        qc, kc, vc, ic, fc = xs
        b = jnp.cumsum(fc, axis=1).transpose(0, 2, 1)
        i = ic.transpose(0, 2, 1)
        log_d = jnp.where(tril, b[..., :, None] - b[..., None, :] + i[..., None, :], NEG_BIG)
        log_inter = b + m[..., None]
        m_t = jnp.maximum(log_inter, log_d.max(axis=-1))
        d = jnp.exp(log_d - m_t[..., None])
        w_inter = jnp.exp(log_inter - m_t)
        s = jnp.einsum('bthd,bshd->bhts', qc, kc).astype(jnp.float32) * d
        num = (jnp.einsum('bhts,bshv->bhtv', s, vc)
               + w_inter[..., None] * jnp.einsum('bhvd,bthd->bhtv', C, qc))
        den = s.sum(axis=-1) + w_inter * jnp.einsum('bhd,bthd->bht', n, qc)
        h = num / jnp.maximum(jnp.abs(den), jnp.exp(-m_t))[..., None]
        b_last = b[..., -1]
        log_w = b_last[..., None] - b + i
        m_new = jnp.maximum(b_last + m, log_w.max(axis=-1))
        w = jnp.exp(log_w - m_new[..., None])
        decay = jnp.exp(b_last + m - m_new)
        C_new = decay[..., None, None] * C + jnp.einsum('bhs,bshv,bshd->bhvd', w, vc, kc)
        n_new = decay[..., None] * n + jnp.einsum('bhs,bshd->bhd', w, kc)
        return (C_new, n_new, m_new), h.transpose(0, 2, 1, 3)

    state, hs = lax.scan(step, state, (chunks(q), chunks(k), chunks(v), chunks(ig), chunks(lf)))
    return state, jnp.moveaxis(hs, 0, 1).reshape(B, L, H, -1)


def mlstm_inputs(q, k, v, g, conv_w, gate_b):
    qk = jax.nn.silu(centred_depthwise_conv(jnp.concatenate([q, k], axis=-1), conv_w))
    q, k = jnp.split(qk, 2, axis=-1)
    heads = lambda a: a.reshape(a.shape[:2] + (C_HEADS, C_HEAD_DIM))
    g = g.astype(jnp.float32) + gate_b.astype(jnp.float32)
    i_f, f_f, i_b, f_b = jnp.split(g, 4, axis=-1)
    qkv = (heads(q), heads(k) * (C_HEAD_DIM ** -0.5), heads(v))
    gates = ((i_f, jax.nn.log_sigmoid(f_f)), (i_b, jax.nn.log_sigmoid(f_b)))
    return qkv, gates


def mlstm_bidirectional(ctx_in, lat_in):
    (qc, kc, vc), gates_c = ctx_in
    (ql, kl, vl), gates_l = lat_in
    B = ql.shape[0]
    outs_c, outs_l = [], []
    for direction in range(2):
        flip = (lambda a: a[:, ::-1]) if direction == 1 else (lambda a: a)
        state0 = (jnp.zeros((B, C_HEADS, C_HEAD_DIM, C_HEAD_DIM), jnp.float32),
                  jnp.zeros((B, C_HEADS, C_HEAD_DIM), jnp.float32),
                  jnp.zeros((B, C_HEADS), jnp.float32))
        ic, fc = gates_c[direction]
        il, fl = gates_l[direction]
        st, hc = mlstm_chunkwise(flip(qc), flip(kc), flip(vc), flip(ic), flip(fc), state0)
        _, hl = mlstm_chunkwise(flip(ql), flip(kl), flip(vl), flip(il), flip(fl), st)
        outs_c.append(flip(hc))
        outs_l.append(flip(hl))
    return outs_c[0] + outs_c[1], outs_l[0] + outs_l[1]


def mlstm_output(h, o, norm_w):
    h = rmsnorm(h.astype(o.dtype), norm_w.reshape(C_HEADS, C_HEAD_DIM))
    return jax.nn.sigmoid(o) * h.reshape(o.shape)


def hybrid_mixer(h_c, h_l, cos, sin, lam_init, w_in, conv_w, gate_b, c_norm_w, lam_vecs, subln_w,
                 q_norm_w, k_norm_w, w_br_a, w_br_b, w_br_c, w_out, with_ctx):
    p_c = split_columns(h_c @ w_in)
    p_l = split_columns(h_l @ w_in)

    lv = lam_vecs.astype(jnp.float32)
    lam = jnp.exp(jnp.sum(lv[0] * lv[1])) - jnp.exp(jnp.sum(lv[2] * lv[3])) + lam_init
    heads_a = lambda a: a.reshape(a.shape[:2] + (A_HEADS, 2, A_HEAD_DIM))
    vheads_a = lambda a: a.reshape(a.shape[:2] + (A_HEADS, 2 * A_HEAD_DIM))
    qa_c, ka_c, va_c = heads_a(p_c[0]), heads_a(p_c[1]), vheads_a(p_c[2])
    qa_l = apply_rope(heads_a(p_l[0]), cos, sin)
    ka_all = jnp.concatenate([ka_c, apply_rope(heads_a(p_l[1]), cos, sin)], axis=1)
    va_all = jnp.concatenate([va_c, vheads_a(p_l[2])], axis=1)
    oa_l = sweep_query_blocks(lambda qblk: diff_attention(qblk, ka_all, va_all, lam, subln_w, lam_init), qa_l)

    heads_b = lambda a, nh: a.reshape(a.shape[:2] + (nh, B_HEAD_DIM))
    qb_c = rmsnorm(heads_b(p_c[3], B_Q_HEADS), q_norm_w)
    kb_c = rmsnorm(heads_b(p_c[4], B_KV_HEADS), k_norm_w)
    vb_c = heads_b(p_c[5], B_KV_HEADS)
    qb_l = apply_rope(rmsnorm(heads_b(p_l[3], B_Q_HEADS), q_norm_w), cos, sin)
    kb_all = jnp.concatenate([kb_c, apply_rope(rmsnorm(heads_b(p_l[4], B_KV_HEADS), k_norm_w), cos, sin)], axis=1)
    vb_all = jnp.concatenate([vb_c, heads_b(p_l[5], B_KV_HEADS)], axis=1)
    ob_l = sweep_query_blocks(lambda qblk: gqa_attention(qblk, kb_all, vb_all), qb_l)

    ctx_in = mlstm_inputs(p_c[6], p_c[7], p_c[8], p_c[10], conv_w, gate_b)
    lat_in = mlstm_inputs(p_l[6], p_l[7], p_l[8], p_l[10], conv_w, gate_b)
    hc_sum, hl_sum = mlstm_bidirectional(ctx_in, lat_in)
    oc_l = mlstm_output(hl_sum, p_l[9], c_norm_w)

    def merge(oa, ob, oc, g):
        gates = jax.nn.sigmoid(g).reshape(g.shape[:2] + (N_BRANCH, D_MODEL))
        merged = (gates[..., 0, :] * (oa @ w_br_a) + gates[..., 1, :] * (ob @ w_br_b)
                  + gates[..., 2, :] * (oc @ w_br_c))
        return merged @ w_out

    y_l = merge(oa_l, ob_l, oc_l, p_l[11])
    y_c = None
    if with_ctx:
        oa_c = diff_attention(qa_c, ka_c, va_c, lam, subln_w, lam_init)
        ob_c = gqa_attention(qb_c, kb_c, vb_c)
        oc_c = mlstm_output(hc_sum, p_c[9], c_norm_w)
        y_c = merge(oa_c, ob_c, oc_c, p_c[11])
    return y_c, y_l


def expert_choice_ffn(h, w_router, w_gate, w_up, w_down):
    B, N, D = h.shape
    cap = EC_CAPACITY_FACTOR * N // N_EXPERTS
    logits = jnp.einsum('bnd,de->bne', h, w_router).astype(jnp.float32)
    aff = jax.nn.softmax(logits, axis=-1).transpose(0, 2, 1)
    g, idx = lax.top_k(aff, cap)
    xe = jax.vmap(lambda hb, ib: hb[ib])(h, idx)
    a = jnp.einsum('becd,edf->becf', xe, w_gate)
    u = jnp.einsum('becd,edf->becf', xe, w_up)
    ye = jnp.einsum('becf,efd->becd', jax.nn.silu(a) * u, w_down) * g[..., None].astype(h.dtype)
    return jax.vmap(lambda yb, ib: jnp.zeros((N, D), yb.dtype).at[ib.reshape(-1)].add(yb.reshape(-1, D)))(ye, idx)


def setup_inputs(seed: int = 0) -> dict:
    key = jax.random.key(seed)
    ks = jax.random.split(key, 32)
    D = D_MODEL
    nrm = lambda k, shape, scale: jax.random.normal(k, shape, jnp.float32) * scale
    gate_b = jnp.concatenate([
        nrm(ks[10], (DEPTH, C_HEADS), 0.1),
        jax.random.uniform(ks[11], (DEPTH, C_HEADS), jnp.float32, 3.0, 6.0),
        nrm(ks[12], (DEPTH, C_HEADS), 0.1),
        jax.random.uniform(ks[13], (DEPTH, C_HEADS), jnp.float32, 3.0, 6.0)], axis=-1)
    return {
        'x': nrm(ks[0], (BATCH, SEQ, D), 1.0),
        'c': nrm(ks[1], (BATCH, D), 1.0),
        'ctx': nrm(ks[2], (BATCH, CTX_LEN, D), 1.0),
        'c_ctx': nrm(ks[3], (D,), 1.0),
        'w_ada': nrm(ks[4], (DEPTH, D, 6 * D), 0.5 * D ** -0.5),
        'b_ada': nrm(ks[5], (DEPTH, 6 * D), 0.02),
        'norm1_w': 1.0 + nrm(ks[6], (DEPTH, D), 0.05),
        'norm2_w': 1.0 + nrm(ks[7], (DEPTH, D), 0.05),
        'w_in': nrm(ks[8], (DEPTH, D, IN_COLS), D ** -0.5),
        'mlstm_conv_w': nrm(ks[9], (DEPTH, C_CONV, 2 * MIX_W), C_CONV ** -0.5),
        'mlstm_gate_b': gate_b,
        'mlstm_norm_w': 1.0 + nrm(ks[14], (DEPTH, MIX_W), 0.05),
        'diff_lambda': nrm(ks[15], (DEPTH, 4, A_HEAD_DIM), 0.1),
        'diff_subln_w': 1.0 + nrm(ks[16], (DEPTH, 2 * A_HEAD_DIM), 0.05),
        'gqa_qnorm_w': 1.0 + nrm(ks[17], (DEPTH, B_HEAD_DIM), 0.05),
        'gqa_knorm_w': 1.0 + nrm(ks[18], (DEPTH, B_HEAD_DIM), 0.05),
        'w_branch_a': nrm(ks[19], (DEPTH, MIX_W, D), MIX_W ** -0.5),
        'w_branch_b': nrm(ks[20], (DEPTH, MIX_W, D), MIX_W ** -0.5),
        'w_branch_c': nrm(ks[21], (DEPTH, MIX_W, D), MIX_W ** -0.5),
        'w_out': nrm(ks[22], (DEPTH, D, D), D ** -0.5),
        'w_router': nrm(ks[23], (DEPTH, D, N_EXPERTS), D ** -0.5),
        'w_exp_gate': nrm(ks[24], (DEPTH, N_EXPERTS, D, EXPERT_FF), D ** -0.5),
        'w_exp_up': nrm(ks[25], (DEPTH, N_EXPERTS, D, EXPERT_FF), D ** -0.5),
        'w_exp_down': nrm(ks[26], (DEPTH, N_EXPERTS, EXPERT_FF, D), EXPERT_FF ** -0.5),
        'final_norm_w': 1.0 + nrm(ks[27], (D,), 0.05),
    }


def reference(x, c, ctx, c_ctx, w_ada, b_ada, norm1_w, norm2_w, w_in, mlstm_conv_w, mlstm_gate_b,
              mlstm_norm_w, diff_lambda, diff_subln_w, gqa_qnorm_w, gqa_knorm_w, w_branch_a, w_branch_b,
              w_branch_c, w_out, w_router, w_exp_gate, w_exp_up, w_exp_down, final_norm_w):
    cos, sin = axial_rope_tables(x.shape[1], A_HEAD_DIM)
    for layer in range(DEPTH):
        with_ctx = layer < DEPTH - 1
        mod_l = (jax.nn.silu(c) @ w_ada[layer] + b_ada[layer])[:, None, :]
        mod_c = (jax.nn.silu(c_ctx) @ w_ada[layer] + b_ada[layer])[None, None, :]
        sh1_l, sc1_l, g1_l, sh2_l, sc2_l, g2_l = jnp.split(mod_l, 6, axis=-1)
        sh1_c, sc1_c, g1_c, sh2_c, sc2_c, g2_c = jnp.split(mod_c, 6, axis=-1)

        h_l = modulate(rmsnorm(x, norm1_w[layer]), sh1_l, sc1_l)
        h_c = modulate(rmsnorm(ctx, norm1_w[layer]), sh1_c, sc1_c)
        y_c, y_l = hybrid_mixer(h_c, h_l, cos, sin, diff_lambda_init(layer), w_in[layer],
                                mlstm_conv_w[layer], mlstm_gate_b[layer], mlstm_norm_w[layer],
                                diff_lambda[layer], diff_subln_w[layer], gqa_qnorm_w[layer],
                                gqa_knorm_w[layer], w_branch_a[layer], w_branch_b[layer],
                                w_branch_c[layer], w_out[layer], with_ctx)
        x = x + g1_l * y_l
        h_l = modulate(rmsnorm(x, norm2_w[layer]), sh2_l, sc2_l)
        x = x + g2_l * expert_choice_ffn(h_l, w_router[layer], w_exp_gate[layer], w_exp_up[layer], w_exp_down[layer])
        if with_ctx:
            ctx = ctx + g1_c * y_c
            h_c = modulate(rmsnorm(ctx, norm2_w[layer]), sh2_c, sc2_c)
            ctx = ctx + g2_c * expert_choice_ffn(h_c, w_router[layer], w_exp_gate[layer], w_exp_up[layer], w_exp_down[layer])
    return rmsnorm(x, final_norm_w)
```

```cpp
#include <hip/hip_runtime.h>
#include <hip/hip_cooperative_groups.h>
#include <hip/hip_bf16.h>
#include <cmath>
#include <cstdio>
#include <cstdint>
namespace cg = cooperative_groups;

#define LAS __attribute__((address_space(3)))
typedef unsigned short bf16_t;
typedef short bf16x8 __attribute__((ext_vector_type(8)));
typedef short s16x4 __attribute__((ext_vector_type(4)));
typedef float f32x2 __attribute__((ext_vector_type(2)));
typedef float f32x4 __attribute__((ext_vector_type(4)));
typedef float f32x16 __attribute__((ext_vector_type(16)));
typedef unsigned u32x2 __attribute__((ext_vector_type(2)));
typedef unsigned u32x4 __attribute__((ext_vector_type(4)));
typedef __bf16 bf16x2_t __attribute__((ext_vector_type(2)));

constexpr int NB = 8, LAT = 2048, CTXL = 256, TOK = CTXL + LAT  , ROWS = NB * TOK  ;
constexpr int DM = 1024, MIXW = 512, NPROJ = 7424  , INCOLS = 7440, NE = 16, FF = 2048;
constexpr int GRIDW = 64;
constexpr float EPS = 1e-6f;
constexpr float C2 = 0.125f * 1.4426950408889634f;
constexpr int PC_AQ = 0, PC_AK = 512, PC_AV = 1024, PC_BQ = 1536, PC_BK = 2048, PC_BV = 2176, PC_CQ = 2304, PC_CK = 2816, PC_CV = 3328, PC_CO = 3840, PC_MG = 4352;
constexpr int NTHREADS = 512, NWAVES = 8;
constexpr int DYN_LDS_BYTES = 155648;

constexpr size_t MiB = (size_t)1 << 20;
constexpr size_t WS_CTL = 0, CTL_BYTES = 1 * MiB;
constexpr size_t WS_MOD = 1 * MiB;
constexpr size_t WS_ROPE = 2 * MiB;
constexpr size_t WS_GATES = 3 * MiB;
constexpr size_t WS_AFF = 5 * MiB;
constexpr size_t WS_SLOT = 7 * MiB;
constexpr size_t WS_GSEL = 9 * MiB;
constexpr size_t WS_WIN = 16 * MiB;
constexpr size_t WS_WBR = 46 * MiB;
constexpr size_t WS_WOUT = 52 * MiB;
constexpr size_t WS_WGU = 56 * MiB;
constexpr size_t WS_WG8 = 184 * MiB;
constexpr size_t WS_WDN = 312 * MiB;
constexpr size_t WS_XR = 440 * MiB;
constexpr size_t WS_H8IN = 476 * MiB;
constexpr size_t WS_H = 512 * MiB;
constexpr size_t WS_P = 548 * MiB;
constexpr size_t WS_OAP = 809 * MiB;
constexpr size_t WS_HF = 845 * MiB;
constexpr size_t WS_MP = WS_HF;
constexpr size_t WS_OABC = 917 * MiB;
constexpr size_t WS_MERGED = 971 * MiB;
constexpr size_t WS_XIDX = 548 * MiB;
constexpr size_t WS_ACT = 620 * MiB;
constexpr size_t WS_YE = 764 * MiB;
constexpr size_t WS_END = 1007 * MiB;
static_assert(WS_P + (size_t)ROWS * NPROJ * 2 <= WS_OAP && WS_MERGED + (size_t)ROWS * 1024 * 2 <= WS_END && WS_YE + (size_t)36864 * 1024 * 2 <= WS_HF, "ws map");
constexpr int CW_BAR = 4096;
constexpr int CW_PHDONE = 512;
constexpr int CW_TRQ = 256;
constexpr int CW_QUEUE = 64;

struct Params {
    const float *x, *c, *ctx, *c_ctx, *w_ada, *b_ada, *norm1_w, *norm2_w, *w_in, *conv_w, *gate_b, *mnorm_w, *dlam, *subln_w, *qnw, *knw,
                *wbr_a, *wbr_b, *wbr_c, *w_out, *w_router, *wg, *wu, *wd, *final_w;
    float* out; unsigned char* ws;
};

__device__ __forceinline__ unsigned cvtpk(float lo, float hi) { f32x2 v = {lo, hi}; bf16x2_t b = __builtin_convertvector(v, bf16x2_t); return __builtin_bit_cast(unsigned, b); }
__device__ __forceinline__ unsigned cvt4_fp8(float a, float b, float c, float d) {
    int w = 0;
    w = __builtin_amdgcn_cvt_pk_fp8_f32(__builtin_amdgcn_fmed3f(a, -448.f, 448.f), __builtin_amdgcn_fmed3f(b, -448.f, 448.f), w, false);
    w = __builtin_amdgcn_cvt_pk_fp8_f32(__builtin_amdgcn_fmed3f(c, -448.f, 448.f), __builtin_amdgcn_fmed3f(d, -448.f, 448.f), w, true);
    return (unsigned)w;
}
__device__ __forceinline__ unsigned cvt4_fp8_nc(float a, float b, float c, float d) { int w = 0; w = __builtin_amdgcn_cvt_pk_fp8_f32(a, b, w, false); w = __builtin_amdgcn_cvt_pk_fp8_f32(c, d, w, true); return (unsigned)w; }
constexpr float F8_WSCALE = 32.0f, F8_ASCALE = 4.0f;
__device__ __forceinline__ float bf2f(unsigned short b) { return __uint_as_float(((unsigned)b) << 16); }
__device__ __forceinline__ float bflo(unsigned w) { return __uint_as_float(w << 16); }
__device__ __forceinline__ float bfhi(unsigned w) { return __uint_as_float(w & 0xffff0000u); }
__device__ __forceinline__ float wave_sum(float v) {
#pragma unroll
    for (int o = 1; o < 64; o <<= 1) v += __shfl_xor(v, o);
    return v;
}
__device__ __forceinline__ float fast_sigmoid(float x) { return __builtin_amdgcn_rcpf(1.0f + __builtin_amdgcn_exp2f(-1.4426950408889634f * x)); }
__device__ __forceinline__ float fast_silu(float x) { return x * fast_sigmoid(x); }
__device__ __forceinline__ int opaque_tid() { int t = threadIdx.x; asm volatile("" : "+v"(t)); return t; }
#define LDS_WAIT() asm volatile("s_waitcnt lgkmcnt(0)" ::: "memory")
#define VM_WAIT() asm volatile("s_waitcnt vmcnt(0)" ::: "memory")
typedef int v8i_t __attribute__((ext_vector_type(8)));
namespace pg8 {
constexpr int BM = 256, BK = 64, HALF = 128, HTB = HALF * BK * 2, STAGE_BYTES = 8 * HTB, NXCD = 8, WGM = 8;
__host__ __device__ __forceinline__ int lds_byte(int r, int c) { const int st = (r >> 4) * 2 + (c >> 5), rr = r & 15, cc = c & 31, ob = rr * 64 + cc * 2; return st * 1024 + (ob ^ (((ob >> 9) & 1) << 5)); }
__host__ __device__ __forceinline__ void stage_rc(int b, int& R, int& C) { const int st = b / 1024, sb = b % 1024, swz = sb ^ (((sb >> 9) & 1) << 5); R = (st >> 1) * 16 + swz / 64; C = (st & 1) * 32 + (swz % 64) / 2; }

struct Unit { int pm, pn, arow, brow; };
struct Gemm { const bf16_t* A; const bf16_t* Bt; int lda, ldb, K; const int* gidx; };

template <class Map, int NN> struct Order {
    int nM, nN, nwg, G, c, wgm; Map map;
    __device__ void init(int nM_, int nN_, int G_, int c_, const Map& m, int wgm_ = WGM) { nM = nM_; nN = NN; nwg = nM * NN; G = G_; c = c_; map = m; wgm = wgm_; (void)nN_; }
    __device__ bool next(int i, Unit& u) const { return at(i * G + c, u); }
    __device__ bool at(int L, Unit& u) const {
        if (L >= nwg) return false;
        int wgid = L; { const int q = nwg / NXCD, r = nwg % NXCD, xcd = wgid % NXCD, off = wgid / NXCD; wgid = (xcd < r ? xcd * (q + 1) : r * (q + 1) + (xcd - r) * q) + off; }
        constexpr int nig = WGM * NN; const int gid = wgid / nig, wl = wgid - gid * nig, fm = gid * WGM, gsz = (nM - fm) < WGM ? (nM - fm) : WGM;
        if (gsz == WGM) { u.pm = fm + (wl & (WGM - 1)); u.pn = wl / WGM; } else { u.pm = fm + wl % gsz; u.pn = wl / gsz; }
        u.arow = map.arow(u.pm); u.brow = map.brow(u.pm, u.pn); return true;
    }
};
struct MapDense {
    int latent_only;
    __device__ int arow(int pm) const { return latent_only ? ((pm >> 3) * 9 + 1 + (pm & 7)) * 256 : pm * 256; }
    __device__ int brow(int, int pn) const { return pn * 256; }
};
struct MapFFN {
    int T, nbe;
    __device__ int arow(int pm) const { const int e = (T == 8) ? (pm >> 3) : pm / 9; return (e * 9 + (pm - e * T)) * 256; }
    __device__ int brow(int pm, int pn) const { const int e = (T == 8) ? (pm >> 3) : pm / 9; return e * nbe + pn * 256; }
};

struct OrderGates {
    Order<MapDense, 12> base; int c, first, nshort, ushort_, ulong_, bal;
    __device__ void init(int layer, int G_, int c_) {
        base.init(layer ? 64 : 72, 12, G_, (c_ + 56) % G_, MapDense{layer});
        c = c_; first = 200; nshort = G_ - first; ushort_ = 5; ulong_ = 3; bal = (layer == 0 && G_ == 256);
    }
    __device__ bool next(int i, Unit& u) const {
        if (!bal) return base.next(i, u);
        if (c >= first) { if (i >= ushort_) return false; return base.at((c - first) + nshort * i, u); }
        if (i >= ulong_) return false; return base.at(ushort_ * nshort + c + first * i, u);
    }
};

struct OrderInProj {
    Order<MapDense, 17> base; int extra;
    __device__ void init(int layer, int G_, int c_) { if (layer == 0) { base.init(72, 17, G_, c_, MapDense{0}); extra = 0; } else { base.init(64, 17, G_, c_, MapDense{1}); extra = 88; } }
    __device__ bool next(int i, Unit& u) const {
        if (base.next(i, u)) return true;
        const int idx = i * base.G + base.c - base.nwg; if (idx >= extra) return false;
        const int b = idx / 11, j = idx % 11; u.pm = b * 9; u.pn = (j < 4) ? 2 + j : (j == 4 ? 8 : 4 + j); u.arow = b * 9 * 256; u.brow = u.pn * 256; return true;
    }
};

template <bool GATHER = false, bool FP8 = false, class Epi, class Sched>
__device__ __forceinline__ void gemm_phase(LAS unsigned char* lds, const Gemm g, const Sched& S, const Epi& E) {
    const int tid = opaque_tid(), wid = __builtin_amdgcn_readfirstlane(tid >> 6), lane = tid & 63, wr = wid >> 2, wc = wid & 3, fr = lane & 15, fq = lane >> 4;
    const int K = g.K, nt = K / BK;
    unsigned voffA[2], voffB[2];
#pragma unroll
    for (int i = 0; i < 2; ++i) { int R, C; stage_rc(tid * 16 + i * 8192, R, C); voffA[i] = (unsigned)(R * g.lda + C) * 2u; voffB[i] = (unsigned)(R * g.ldb + C) * 2u; }
    const size_t kstep = (size_t)(BK * 2);
    const size_t hstepA = (size_t)HALF * g.lda * 2, hstepB = (size_t)HALF * g.ldb * 2;
    const unsigned ldsw = (unsigned)wid * 1024u;
    const int aoff = lds_byte(wr * 64 + fr, fq * 8), boff = lds_byte(wc * 32 + fr, fq * 8);
#define PG8_SA(b, h) (((b) * 2 + (h)) * HTB)
#define PG8_SB(b, h) ((4 + (b) * 2 + (h)) * HTB)
#define PG8_STAGE(bufoff, gbase, voff) do { _Pragma("unroll") for (int _i = 0; _i < 2; ++_i) \
        __builtin_amdgcn_global_load_lds((const unsigned*)((const char*)(gbase) + (voff)[_i]), (LAS unsigned*)(lds + (bufoff) + ldsw + _i * 8192), 16, 0, 0); } while (0)
    unsigned vAc[2][2], vAn[2][2]; int gi[2][2];
#define PG8_GI_ISSUE(ar) do { _Pragma("unroll") for (int _h = 0; _h < 2; ++_h) _Pragma("unroll") for (int _i = 0; _i < 2; ++_i) { int R_, C_; stage_rc(tid * 16 + _i * 8192, R_, C_); gi[_h][_i] = g.gidx[(ar) + _h * HALF + R_]; } } while (0)
#define PG8_GI_ISSUE_ASM(ar) do { _Pragma("unroll") for (int _h = 0; _h < 2; ++_h) _Pragma("unroll") for (int _i = 0; _i < 2; ++_i) { int R_, C_; stage_rc(tid * 16 + _i * 8192, R_, C_); const int* ip_ = g.gidx + ((ar) + _h * HALF + R_); \
        asm volatile("global_load_dword %0, %1, off" : "=v"(gi[_h][_i]) : "v"(ip_) : "memory"); } } while (0)
#define PG8_GI_CONV(v) do { _Pragma("unroll") for (int _h = 0; _h < 2; ++_h) _Pragma("unroll") for (int _i = 0; _i < 2; ++_i) { int R_, C_; stage_rc(tid * 16 + _i * 8192, R_, C_); v[_h][_i] = (unsigned)(gi[_h][_i] * g.lda + C_) * 2u; } } while (0)
#define PG8_STA(bufoff, basep, kb, nx, h) do { if constexpr (GATHER) { const char* gb_ = (const char*)g.A + (kb); _Pragma("unroll") for (int _i = 0; _i < 2; ++_i) { const unsigned vo_ = (nx) ? vAn[h][_i] : vAc[h][_i]; \
        __builtin_amdgcn_global_load_lds((const unsigned*)(gb_ + vo_), (LAS unsigned*)(lds + (bufoff) + ldsw + _i * 8192), 16, 0, 0); } } else PG8_STAGE(bufoff, basep, voffA); } while (0)
#define PG8_LDA(dst, b, h) do { _Pragma("unroll") for (int m = 0; m < 4; ++m) _Pragma("unroll") for (int k = 0; k < 2; ++k) dst[m][k] = *(const LAS bf16x8*)(lds + PG8_SA(b, h) + aoff + m * 2048 + k * 1024); } while (0)
#define PG8_LDB(dst, b, h) do { _Pragma("unroll") for (int n = 0; n < 2; ++n) _Pragma("unroll") for (int k = 0; k < 2; ++k) dst[n][k] = *(const LAS bf16x8*)(lds + PG8_SB(b, h) + boff + n * 2048 + k * 1024); } while (0)
#define PG8_CAT(x0, x1) ({ const u32x4 p_ = __builtin_bit_cast(u32x4, x0), q_ = __builtin_bit_cast(u32x4, x1); (v8i_t){(int)p_.x, (int)p_.y, (int)p_.z, (int)p_.w, (int)q_.x, (int)q_.y, (int)q_.z, (int)q_.w}; })
#define PG8_MMA(ai, bj, At, Bt) do { __builtin_amdgcn_s_setprio(1); if constexpr (FP8) { v8i_t a8_[4], b8_[2]; _Pragma("unroll") for (int m = 0; m < 4; ++m) a8_[m] = PG8_CAT(At[m][0], At[m][1]); \
        _Pragma("unroll") for (int n = 0; n < 2; ++n) b8_[n] = PG8_CAT(Bt[n][0], Bt[n][1]); \
        _Pragma("unroll") for (int m = 0; m < 4; ++m) _Pragma("unroll") for (int n = 0; n < 2; ++n) asm volatile("v_mfma_f32_16x16x128_f8f6f4 %0, %1, %2, %0" : "+v"(acc[ai][bj][m][n]) : "v"(b8_[n]), "v"(a8_[m])); } else { \
        _Pragma("unroll") for (int m = 0; m < 4; ++m) _Pragma("unroll") for (int n = 0; n < 2; ++n) _Pragma("unroll") for (int k = 0; k < 2; ++k) \
        acc[ai][bj][m][n] = __builtin_amdgcn_mfma_f32_16x16x32_bf16(Bt[n][k], At[m][k], acc[ai][bj][m][n], 0, 0, 0); } __builtin_amdgcn_s_setprio(0); } while (0)
#define PG8_WAIT_V(n) asm volatile("s_waitcnt vmcnt(" #n ")" ::: "memory")
#define PG8_WAIT_L(n) asm volatile("s_waitcnt lgkmcnt(" #n ")" ::: "memory")
#define PG8_BAR __builtin_amdgcn_s_barrier()
#define PG8_SCHED __builtin_amdgcn_sched_barrier(0)
    Unit cur, nxt; int ui = 0;
    if (!S.next(0, cur)) return;
    f32x4 acc[2][2][4][2];
#pragma unroll
    for (int a = 0; a < 2; ++a)
#pragma unroll
        for (int b = 0; b < 2; ++b)
#pragma unroll
            for (int m = 0; m < 4; ++m)
#pragma unroll
                for (int n = 0; n < 2; ++n) acc[a][b][m][n] = (f32x4){0.f, 0.f, 0.f, 0.f};
    bf16x8 At[4][2], B0[2][2], B1[2][2];
    const char* cA = (const char*)g.A + (size_t)cur.arow * g.lda * 2; const char* cB = (const char*)g.Bt + (size_t)cur.brow * g.ldb * 2;
    if constexpr (GATHER) { PG8_GI_ISSUE(cur.arow); PG8_GI_CONV(vAc); Unit u1; const bool h1 = S.next(1, u1); const int ar1 = h1 ? u1.arow : cur.arow; PG8_GI_ISSUE(ar1); PG8_GI_CONV(vAn); }
    PG8_STAGE(PG8_SB(0, 0), cB, voffB); PG8_STAGE(PG8_SB(0, 1), cB + hstepB, voffB); PG8_STA(PG8_SA(0, 0), cA, 0, false, 0); PG8_STA(PG8_SA(0, 1), cA + hstepA, 0, false, 1);
    if (wr == 1) PG8_BAR;
    PG8_WAIT_V(2); PG8_BAR;
    PG8_STAGE(PG8_SB(1, 0), cB + kstep, voffB); PG8_STA(PG8_SA(1, 0), cA + kstep, kstep, false, 0); PG8_STAGE(PG8_SB(1, 1), cB + hstepB + kstep, voffB);
    PG8_WAIT_V(6); PG8_BAR;
    for (;;) {
        const bool has_next = S.next(ui + 1, nxt);
        const char* nA = has_next ? (const char*)g.A + (size_t)nxt.arow * g.lda * 2 : cA; const char* nB = has_next ? (const char*)g.Bt + (size_t)nxt.brow * g.ldb * 2 : cB;
#pragma unroll 1
        for (int t = 0; t < nt; t += 2) {
            if constexpr (Epi::HAS_MID) { if (E.mid_at(t)) E.mid(acc, cur, t, wr, wc, fr, fq); }
            const bool last = (t == nt - 2);
            const char* a1 = cA + (size_t)(t + 1) * kstep;
            const char* a2 = last ? nA : cA + (size_t)(t + 2) * kstep; const char* b2 = last ? nB : cB + (size_t)(t + 2) * kstep;
            const char* a3 = a2 + kstep; const char* b3 = b2 + kstep;
            const size_t kb1 = (size_t)(t + 1) * kstep, kb2 = last ? (size_t)0 : (size_t)(t + 2) * kstep;
            PG8_LDB(B0, 0, 0); PG8_LDB(B1, 0, 1); PG8_SCHED; PG8_LDA(At, 0, 0); PG8_STA(PG8_SA(1, 1), a1 + hstepA, kb1, false, 1);
            PG8_WAIT_V(8); PG8_WAIT_L(0); PG8_BAR; PG8_MMA(0, 0, At, B0); PG8_MMA(0, 1, At, B1); PG8_BAR; PG8_SCHED;
            PG8_LDA(At, 0, 1); PG8_STAGE(PG8_SB(0, 0), b2, voffB); PG8_STAGE(PG8_SB(0, 1), b2 + hstepB, voffB); PG8_STA(PG8_SA(0, 0), a2, kb2, last, 0);
            PG8_WAIT_V(8); PG8_WAIT_L(0); PG8_BAR; PG8_MMA(1, 0, At, B0); PG8_MMA(1, 1, At, B1); PG8_BAR; PG8_SCHED;
            PG8_LDB(B0, 1, 0); PG8_LDB(B1, 1, 1); PG8_SCHED; PG8_LDA(At, 1, 0); PG8_STA(PG8_SA(0, 1), a2 + hstepA, kb2, last, 1);
            PG8_WAIT_V(8); PG8_WAIT_L(0); PG8_BAR; PG8_MMA(0, 0, At, B0); PG8_MMA(0, 1, At, B1); PG8_BAR; PG8_SCHED;
            PG8_LDA(At, 1, 1); PG8_STAGE(PG8_SB(1, 0), b3, voffB); PG8_STAGE(PG8_SB(1, 1), b3 + hstepB, voffB); PG8_STA(PG8_SA(1, 0), a3, kb2 + kstep, last, 0);
            PG8_WAIT_V(8); PG8_WAIT_L(0); PG8_BAR; PG8_MMA(1, 0, At, B0); PG8_MMA(1, 1, At, B1); PG8_BAR; PG8_SCHED;
        }
        if (wr == 0) PG8_BAR;
        if constexpr (FP8) { asm volatile("s_nop 15\n\ts_nop 15" ::: "memory"); PG8_SCHED; }
        if constexpr (GATHER) { Unit u2; const bool h2 = S.next(ui + 2, u2); const int ar2 = h2 ? u2.arow : cur.arow; PG8_GI_ISSUE_ASM(ar2); }
        E(acc, cur, wr, wc, fr, fq);
        unsigned vNN[2][2];
        if constexpr (GATHER) { static_assert(!GATHER || Epi::NSTORES == 8, "the counted wait below assumes the epilogue's store count");
            asm volatile("s_waitcnt vmcnt(8)" : "+v"(gi[0][0]), "+v"(gi[0][1]), "+v"(gi[1][0]), "+v"(gi[1][1]) :: "memory");
            PG8_GI_CONV(vNN); }
        if (!has_next) break;
        if constexpr (GATHER) {
#pragma unroll
            for (int h = 0; h < 2; ++h)
#pragma unroll
                for (int i = 0; i < 2; ++i) { vAc[h][i] = vAn[h][i]; vAn[h][i] = vNN[h][i]; } }
#pragma unroll
        for (int a = 0; a < 2; ++a)
#pragma unroll
            for (int b = 0; b < 2; ++b)
#pragma unroll
                for (int m = 0; m < 4; ++m)
#pragma unroll
                    for (int n = 0; n < 2; ++n) acc[a][b][m][n] = (f32x4){0.f, 0.f, 0.f, 0.f};
        cur = nxt; cA = nA; cB = nB; ++ui;
        if (wr == 1) PG8_BAR;
    }
    PG8_WAIT_V(0);
    PG8_BAR;
#undef PG8_SA
#undef PG8_SB
#undef PG8_STAGE
#undef PG8_STA
#undef PG8_GI_ISSUE
#undef PG8_GI_ISSUE_ASM
#undef PG8_GI_CONV
#undef PG8_LDA
#undef PG8_LDB
#undef PG8_MMA
#undef PG8_CAT
#undef PG8_WAIT_V
#undef PG8_WAIT_L
#undef PG8_BAR
#undef PG8_SCHED
}

typedef const f32x4 (&AccRef)[2][2][4][2];

__device__ __forceinline__ u32x4 pack8(f32x4 a, f32x4 b) { u32x4 w; w.x = cvtpk(a[0], a[1]); w.y = cvtpk(a[2], a[3]); w.z = cvtpk(b[0], b[1]); w.w = cvtpk(b[2], b[3]); return w; }

struct EpiInProj {
    static constexpr bool HAS_MID = false;
    bf16_t* P; const float* cosT; const float* sinT; const float* qnw; const float* knw;
    __device__ __forceinline__ void operator()(AccRef acc, const Unit& u, int wr, int wc, int fr, int fq_in) const {
        int fq = fq_in; asm volatile("" : "+v"(fq));
        const int pn = u.pn;
        int kind;
        if (pn < 2) kind = 1; else if (pn < 4) kind = 2; else if (pn < 6) kind = 0; else if (pn < 8) kind = 3; else if (pn == 8) kind = (wc < 2) ? 4 : 0; else if (pn < 15) kind = 0; else kind = 5;
        const int tb = u.arow % TOK;
        const bool lat = tb != 0;
        bf16_t* const pbase = P + (size_t)u.arow * NPROJ + pn * 256 + wc * 64 + fq * 8;
        if (kind == 0 || kind == 5) {
#pragma unroll
            for (int ai = 0; ai < 2; ++ai)
#pragma unroll
                for (int m = 0; m < 4; ++m) {
                    const int rl = ai * HALF + wr * 64 + m * 16 + fr;
#pragma unroll
                    for (int bj = 0; bj < 2; ++bj) {
                        f32x4 a = acc[ai][bj][m][0], b = acc[ai][bj][m][1];
                        if (kind == 5) {
#pragma unroll
                            for (int j = 0; j < 4; ++j) { a[j] = fast_sigmoid(a[j]); b[j] = fast_sigmoid(b[j]); } }
                        *(u32x4*)(pbase + (size_t)rl * NPROJ + bj * 32) = pack8(a, b);
                    }
                }
            return;
        }
        f32x4 nw[2][2];
        { const float* w = (kind == 3) ? qnw : knw;
#pragma unroll
            for (int bj = 0; bj < 2; ++bj)
#pragma unroll
                for (int n = 0; n < 2; ++n) nw[bj][n] = *(const f32x4*)(w + 32 * bj + 8 * fq + 4 * n);
            asm volatile("" :: "v"(nw[0][0]), "v"(nw[0][1]), "v"(nw[1][0]), "v"(nw[1][1])); }
        const int tl0 = lat ? tb - CTXL + wr * 64 + fr : 0, tlm = lat ? 1 : 0;
        constexpr int RB = 2;
#pragma unroll
        for (int r0 = 0; r0 < 8; r0 += RB) {
            f32x4 cs[RB][2], sn[RB][2];
#pragma unroll
            for (int q = 0; q < RB; ++q) { const int rI = r0 + q; const int tl = tl0 + tlm * ((rI >> 2) * HALF + (rI & 3) * 16);
#pragma unroll
                for (int n = 0; n < 2; ++n) { cs[q][n] = *(const f32x4*)(cosT + (size_t)tl * 32 + 8 * fq + 4 * n); sn[q][n] = *(const f32x4*)(sinT + (size_t)tl * 32 + 8 * fq + 4 * n); } }
#pragma unroll
            for (int q = 0; q < RB; ++q) {
                const int rI = r0 + q, ai = rI >> 2, m = rI & 3;
                const int rl = ai * HALF + wr * 64 + m * 16 + fr;
                f32x4 v[2][2];
#pragma unroll
                for (int bj = 0; bj < 2; ++bj)
#pragma unroll
                    for (int n = 0; n < 2; ++n) v[bj][n] = acc[ai][bj][m][n];
                asm volatile("" :: "v"(cs[q][0]), "v"(cs[q][1]), "v"(sn[q][0]), "v"(sn[q][1]));
                if (kind == 3 || kind == 4) {
                    float s = 0.f;
#pragma unroll
                    for (int bj = 0; bj < 2; ++bj)
#pragma unroll
                        for (int n = 0; n < 2; ++n) { const f32x4 x = v[bj][n]; s += (x[0] * x[0] + x[1] * x[1]) + (x[2] * x[2] + x[3] * x[3]); }
                    s += __shfl_xor(s, 16); s += __shfl_xor(s, 32);
                    const float r = rsqrtf(s * (1.0f / 64.0f) + EPS);
#pragma unroll
                    for (int bj = 0; bj < 2; ++bj)
#pragma unroll
                        for (int n = 0; n < 2; ++n) v[bj][n] = v[bj][n] * r * nw[bj][n];
                }
                if (lat) {
#pragma unroll
                    for (int n = 0; n < 2; ++n) { const f32x4 x1 = v[0][n], x2 = v[1][n]; v[0][n] = x1 * cs[q][n] - x2 * sn[q][n]; v[1][n] = x1 * sn[q][n] + x2 * cs[q][n]; }
                }
                if (kind == 1 || kind == 3) {
#pragma unroll
                    for (int bj = 0; bj < 2; ++bj)
#pragma unroll
                        for (int n = 0; n < 2; ++n) v[bj][n] = v[bj][n] * C2;
                }
#pragma unroll
                for (int bj = 0; bj < 2; ++bj) *(u32x4*)(pbase + (size_t)rl * NPROJ + bj * 32) = pack8(v[bj][0], v[bj][1]);
            }
            __builtin_amdgcn_sched_barrier(0);
        }
    }
};

struct EpiGates {
    static constexpr bool HAS_MID = false;
    bf16_t* P;
    __device__ __forceinline__ void operator()(AccRef acc, const Unit& u, int wr, int wc, int fr, int fq_in) const {
        int fq = fq_in; asm volatile("" : "+v"(fq));
        bf16_t* const pbase = P + (size_t)u.arow * NPROJ + (17 + u.pn) * 256 + wc * 64 + fq * 8;
        constexpr float inv = 1.0f / F8_WSCALE;
#pragma unroll
        for (int ai = 0; ai < 2; ++ai)
#pragma unroll
            for (int m = 0; m < 4; ++m) {
                const int rl = ai * HALF + wr * 64 + m * 16 + fr;
#pragma unroll
                for (int bj = 0; bj < 2; ++bj) {
                    f32x4 a = acc[ai][bj][m][0], b = acc[ai][bj][m][1];
#pragma unroll
                    for (int j = 0; j < 4; ++j) { a[j] = __builtin_amdgcn_rcpf(1.0f + __builtin_amdgcn_exp2f(a[j] * (-1.4426950408889634f * inv))); b[j] = __builtin_amdgcn_rcpf(1.0f + __builtin_amdgcn_exp2f(b[j] * (-1.4426950408889634f * inv))); }
                    *(u32x4*)(pbase + (size_t)rl * NPROJ + bj * 32) = pack8(a, b);
                }
            }
    }
};

struct EpiMerge {
    static constexpr bool HAS_MID = true;
    const bf16_t* P; bf16_t* OUT;
    __device__ __forceinline__ bool mid_at(int t) const { return t == 8 || t == 16; }
    template <class Acc> __device__ __forceinline__ void mid(Acc& acc, const Unit& u, int t, int wr, int wc, int fr_in, int fq_in) const {
        int fq = fq_in, fr = fr_in; asm volatile("" : "+v"(fq), "+v"(fr));
        const int br = (t >> 3) - 1;
        const bf16_t* gbase = P + ((size_t)u.arow + wr * 64 + fr) * NPROJ + PC_MG + br * 1024 + u.pn * 256 + wc * 64 + fq * 8;
#pragma unroll
        for (int hb = 0; hb < 2; ++hb) {
            u32x4 ga[4][2], gb[4][2];
#pragma unroll
            for (int q = 0; q < 4; ++q) { const bf16_t* rp = gbase + (size_t)(hb * HALF + q * 16) * NPROJ;
#pragma unroll
                for (int bj = 0; bj < 2; ++bj) { ga[q][bj] = *(const u32x4*)(rp + bj * 32); gb[q][bj] = *(const u32x4*)(rp + bj * 32 + 1024); } }
#pragma unroll
            for (int q = 0; q < 4; ++q)
#pragma unroll
                for (int bj = 0; bj < 2; ++bj) {
                    f32x4 r0 = {bflo(ga[q][bj].x), bfhi(ga[q][bj].x), bflo(ga[q][bj].y), bfhi(ga[q][bj].y)}, r1 = {bflo(ga[q][bj].z), bfhi(ga[q][bj].z), bflo(ga[q][bj].w), bfhi(ga[q][bj].w)};
                    const f32x4 d0 = {bflo(gb[q][bj].x), bfhi(gb[q][bj].x), bflo(gb[q][bj].y), bfhi(gb[q][bj].y)}, d1 = {bflo(gb[q][bj].z), bfhi(gb[q][bj].z), bflo(gb[q][bj].w), bfhi(gb[q][bj].w)};
#pragma unroll
                    for (int j = 0; j < 4; ++j) { r0[j] = r0[j] * __builtin_amdgcn_rcpf(fmaxf(d0[j], 1e-30f)); r1[j] = r1[j] * __builtin_amdgcn_rcpf(fmaxf(d1[j], 1e-30f)); }
                    acc[hb][bj][q][0] = acc[hb][bj][q][0] * r0; acc[hb][bj][q][1] = acc[hb][bj][q][1] * r1;
                }
            __builtin_amdgcn_sched_barrier(0);
        }
    }
    __device__ __forceinline__ void operator()(AccRef acc, const Unit& u, int wr, int wc, int fr, int fq_in) const {
        int fq = fq_in; asm volatile("" : "+v"(fq));
        const size_t r0 = (size_t)u.arow + wr * 64 + fr; const int col0 = u.pn * 256 + wc * 64 + fq * 8;
        const bf16_t* gbase = P + r0 * NPROJ + PC_MG + 2 * 1024 + col0; bf16_t* obase = OUT + r0 * 1024 + col0;
        u32x4 gw[8][2];
#pragma unroll
        for (int rI = 0; rI < 8; ++rI)
#pragma unroll
            for (int bj = 0; bj < 2; ++bj) gw[rI][bj] = *(const u32x4*)(gbase + (size_t)((rI >> 2) * HALF + (rI & 3) * 16) * NPROJ + bj * 32);
#pragma unroll
        for (int rI = 0; rI < 8; ++rI) {
            const int ai = rI >> 2, m = rI & 3; const size_t ro = (size_t)(ai * HALF + m * 16);
#pragma unroll
            for (int bj = 0; bj < 2; ++bj) {
                const u32x4 g = gw[rI][bj];
                const f32x4 a = acc[ai][bj][m][0] * (f32x4){bflo(g.x), bfhi(g.x), bflo(g.y), bfhi(g.y)}, b = acc[ai][bj][m][1] * (f32x4){bflo(g.z), bfhi(g.z), bflo(g.w), bfhi(g.w)};
                *(u32x4*)(obase + ro * 1024 + bj * 32) = pack8(a, b);
            }
        }
    }
};

struct EpiOut {
    static constexpr bool HAS_MID = false;
    const float* xin; const float* ctxin; bf16_t* XR; const float* mod; int layer;
    __device__ __forceinline__ void operator()(AccRef acc, const Unit& u, int wr, int wc, int fr, int fq_in) const {
        int fq = fq_in; asm volatile("" : "+v"(fq));
        const int b = u.arow / TOK, tb = u.arow % TOK; const int bm = (tb == 0) ? 8 : b;
        const int col0 = u.pn * 256 + wc * 64 + fq * 8;
        const float* g1 = mod + (size_t)bm * 6144 + 2048 + col0;
        f32x4 gv[2][2];
#pragma unroll
        for (int bj = 0; bj < 2; ++bj)
#pragma unroll
            for (int n = 0; n < 2; ++n) gv[bj][n] = *(const f32x4*)(g1 + bj * 32 + 4 * n);
        bf16_t* dst0 = XR + ((size_t)u.arow + wr * 64 + fr) * 1024 + col0;
        if (layer == 0) {
            const float* src0 = ((tb == 0) ? ctxin + ((size_t)b * CTXL + wr * 64 + fr) * 1024 : xin + ((size_t)b * LAT + (tb - CTXL) + wr * 64 + fr) * 1024) + col0;
            f32x4 xa[2][2][2];
#pragma unroll
            for (int hb = 0; hb < 4; ++hb) {
#pragma unroll
                for (int q = 0; q < 2; ++q)
#pragma unroll
                    for (int bj = 0; bj < 2; ++bj)
#pragma unroll
                        for (int n = 0; n < 2; ++n) xa[q][bj][n] = *(const f32x4*)(src0 + (size_t)((hb >> 1) * HALF + (2 * (hb & 1) + q) * 16) * 1024 + bj * 32 + 4 * n);
#pragma unroll
                for (int q = 0; q < 2; ++q)
#pragma unroll
                    for (int bj = 0; bj < 2; ++bj) { const int ai = hb >> 1, m = 2 * (hb & 1) + q;
                        *(u32x4*)(dst0 + (size_t)(ai * HALF + m * 16) * 1024 + bj * 32) = pack8(xa[q][bj][0] + gv[bj][0] * acc[ai][bj][m][0], xa[q][bj][1] + gv[bj][1] * acc[ai][bj][m][1]); }
                __builtin_amdgcn_sched_barrier(0);
            }
        } else {
            u32x4 xo[4][2];
#pragma unroll
            for (int hb = 0; hb < 2; ++hb) {
#pragma unroll
                for (int q = 0; q < 4; ++q)
#pragma unroll
                    for (int bj = 0; bj < 2; ++bj) xo[q][bj] = *(const u32x4*)(dst0 + (size_t)(hb * HALF + q * 16) * 1024 + bj * 32);
#pragma unroll
                for (int q = 0; q < 4; ++q)
#pragma unroll
                    for (int bj = 0; bj < 2; ++bj) { const u32x4 w = xo[q][bj];
                        const f32x4 x0 = {bflo(w.x), bfhi(w.x), bflo(w.y), bfhi(w.y)}, x1 = {bflo(w.z), bfhi(w.z), bflo(w.w), bfhi(w.w)};
                        *(u32x4*)(dst0 + (size_t)(hb * HALF + q * 16) * 1024 + bj * 32) = pack8(x0 + gv[bj][0] * acc[hb][bj][q][0], x1 + gv[bj][1] * acc[hb][bj][q][1]); }
                __builtin_amdgcn_sched_barrier(0);
            }
        }
    }
};

struct EpiGateUp {
    static constexpr bool HAS_MID = false; static constexpr int NSTORES = 8;
    unsigned char* ACT;
    __device__ __forceinline__ void operator()(AccRef acc, const Unit& u, int wr, int wc, int fr, int fq_in) const {
        int fq = fq_in; asm volatile("" : "+v"(fq));
        constexpr float inv = 1.0f / F8_WSCALE, invs = F8_ASCALE / F8_WSCALE;
#pragma unroll
        for (int ai = 0; ai < 2; ++ai)
#pragma unroll
            for (int m = 0; m < 4; ++m) {
                const size_t row = (size_t)u.arow + ai * HALF + wr * 64 + m * 16 + fr;
                f32x4 o[2];
#pragma unroll
                for (int n = 0; n < 2; ++n)
#pragma unroll
                    for (int j = 0; j < 4; ++j) o[n][j] = fast_silu(acc[ai][0][m][n][j] * inv) * (acc[ai][1][m][n][j] * invs);
                *(u32x2*)(ACT + row * 2048 + u.pn * 128 + wc * 32 + fq * 8) = (u32x2){cvt4_fp8(o[0][0], o[0][1], o[0][2], o[0][3]), cvt4_fp8(o[1][0], o[1][1], o[1][2], o[1][3])};
            }
    }
};

struct EpiDown {
    static constexpr bool HAS_MID = false;
    bf16_t* YE; const float* GSEL;
    __device__ __forceinline__ void operator()(AccRef acc, const Unit& u, int wr, int wc, int fr, int fq_in) const {
        int fq = fq_in; asm volatile("" : "+v"(fq));
        float gs[8];
#pragma unroll
        for (int rI = 0; rI < 8; ++rI) gs[rI] = GSEL[(size_t)u.arow + (rI >> 2) * HALF + wr * 64 + (rI & 3) * 16 + fr];
#pragma unroll
        for (int ai = 0; ai < 2; ++ai)
#pragma unroll
            for (int m = 0; m < 4; ++m) {
                const size_t row = (size_t)u.arow + ai * HALF + wr * 64 + m * 16 + fr;
                const float g = gs[ai * 4 + m] * (1.0f / (F8_WSCALE * F8_ASCALE));
#pragma unroll
                for (int bj = 0; bj < 2; ++bj)
                    *(u32x4*)(YE + row * 1024 + u.pn * 256 + wc * 64 + bj * 32 + fq * 8) = pack8(acc[ai][bj][m][0] * g, acc[ai][bj][m][1] * g);
            }
    }
};
}
namespace attn_body {
using bf16=__hip_bfloat16;
using bf16x8=__attribute__((ext_vector_type(8)))short;
using s16x4=__attribute__((ext_vector_type(4)))short;
using f32x16=__attribute__((ext_vector_type(16)))float;
using u32x4=__attribute__((ext_vector_type(4)))unsigned;
constexpr int D=64,DM=7424;
constexpr int NW=8,QBLK=32,QB=QBLK*NW,KVBLK=64;
__device__ __forceinline__ int crow(int r,int hi){return (r&3)+8*(r>>2)+4*hi;}
#define SBAR() __builtin_amdgcn_sched_barrier(0)
__device__ __forceinline__ void cmask(f32x16&p0,f32x16&p1,int jb,int qrel,int hi){
  const float NEG=-INFINITY; int kb=64*jb+4*hi;
  #pragma unroll
  for(int r=0;r<16;++r){int kv=kb+(r&3)+8*(r>>2); if(kv>qrel)p0[r]=NEG; if(kv+32>qrel)p1[r]=NEG;}
}

constexpr int NSLOT=3, SLOTB=8192;
constexpr int LDS_K=0, LDS_V=NSLOT*SLOTB, LDS_WS=2*NSLOT*SLOTB, LDS_OST=LDS_WS+NW*64*4, LDS_BYTES=LDS_OST+NW*4096;
constexpr float C2=0.125f*1.4426950408889634f;
__device__ __forceinline__ void glds16(const void*gsrc,unsigned lds_dst){unsigned keep;
  asm volatile("s_mov_b32 %0, m0\n\ts_mov_b32 m0, %2\n\ts_nop 0\n\tglobal_load_lds_dwordx4 %1, off\n\ts_mov_b32 m0, %0":"=&s"(keep):"v"(gsrc),"s"(lds_dst):"memory");}
__device__ __forceinline__ float max3f(float a,float b,float c){float r;asm("v_max3_f32 %0, %1, %2, %3":"=v"(r):"v"(a),"v"(b),"v"(c));return r;}
__device__ __forceinline__ float max2f(float a,float b){float r;asm("v_max_f32_e32 %0, %1, %2":"=v"(r):"v"(a),"v"(b));return r;}
__device__ __forceinline__ float fadd_s(float a,float b){float r;asm("v_add_f32_e32 %0, %1, %2":"=v"(r):"v"(a),"v"(b));return r;}
__device__ __forceinline__ float fsub_s(float a,float b){float r;asm("v_sub_f32_e32 %0, %1, %2":"=v"(r):"v"(a),"v"(b));return r;}
typedef float f32x2_t __attribute__((ext_vector_type(2))); typedef __bf16 bf16x2_t __attribute__((ext_vector_type(2)));
__device__ __forceinline__ unsigned cvtpk_s(float lo,float hi){f32x2_t v={lo,hi};bf16x2_t b=__builtin_convertvector(v,bf16x2_t);return __builtin_bit_cast(unsigned,b);}
#define WAIT_BAR(N) asm volatile("s_waitcnt vmcnt(" #N ") lgkmcnt(0)\n\ts_barrier":::"memory")

__device__ __forceinline__ void qkt(f32x16&p0,f32x16&p1,const char*Kslot,const bf16x8*qr,const f32x16&negm,int r32,int hi){
  const char*kb=Kslot+hi*1024+r32*16;
  #pragma unroll
  for(int d0=0;d0<4;++d0){
    const bf16x8 b0=*reinterpret_cast<const bf16x8*>(kb+d0*2048);
    const bf16x8 b1=*reinterpret_cast<const bf16x8*>(kb+d0*2048+512);
    if(d0==0){p0=__builtin_amdgcn_mfma_f32_32x32x16_bf16(b0,qr[0],negm,0,0,0);p1=__builtin_amdgcn_mfma_f32_32x32x16_bf16(b1,qr[0],negm,0,0,0);}
    else{p0=__builtin_amdgcn_mfma_f32_32x32x16_bf16(b0,qr[d0],p0,0,0,0);p1=__builtin_amdgcn_mfma_f32_32x32x16_bf16(b1,qr[d0],p1,0,0,0);}}
}
typedef __attribute__((address_space(3))) const char* lds_cptr;
typedef short v4i16_t __attribute__((ext_vector_type(4)));
__device__ __forceinline__ void kload8(bf16x8*kf,lds_cptr kp){
  kf[0]=*(const __attribute__((address_space(3))) bf16x8*)(kp);      kf[1]=*(const __attribute__((address_space(3))) bf16x8*)(kp+512);
  kf[2]=*(const __attribute__((address_space(3))) bf16x8*)(kp+2048); kf[3]=*(const __attribute__((address_space(3))) bf16x8*)(kp+2560);
  kf[4]=*(const __attribute__((address_space(3))) bf16x8*)(kp+4096); kf[5]=*(const __attribute__((address_space(3))) bf16x8*)(kp+4608);
  kf[6]=*(const __attribute__((address_space(3))) bf16x8*)(kp+6144); kf[7]=*(const __attribute__((address_space(3))) bf16x8*)(kp+6656);
}
__device__ __forceinline__ void kload2(bf16x8*kf,lds_cptr kp,int j){ kf[2*j]=*(const __attribute__((address_space(3))) bf16x8*)(kp+j*2048); kf[2*j+1]=*(const __attribute__((address_space(3))) bf16x8*)(kp+j*2048+512); }
__device__ __forceinline__ s16x4 vtr(lds_cptr p){ return __builtin_bit_cast(s16x4,__builtin_amdgcn_ds_read_tr16_b64_v4i16((__attribute__((address_space(3))) v4i16_t*)p)); }
__device__ __forceinline__ float rowmax(const f32x16&p0,const f32x16&p1){
  float a=max3f(p0[0],p0[1],p1[0]),b=max3f(p0[2],p0[3],p1[1]);a=max3f(a,p1[2],p1[3]);
  #pragma unroll
  for(int r=4;r<16;r+=4){a=max3f(a,p0[r],p0[r+1]);b=max3f(b,p0[r+2],p0[r+3]);a=max3f(a,p1[r],p1[r+1]);b=max3f(b,p1[r+2],p1[r+3]);}
  const float m=max2f(a,b);
  auto rr=__builtin_amdgcn_permlane32_swap(__float_as_uint(m),__float_as_uint(m),false,false);
  return max2f(__uint_as_float(rr[0]),__uint_as_float(rr[1]));
}
__device__ __forceinline__ void pv(f32x16*o,int vb,bf16x8 pa0,bf16x8 pa1,bf16x8 pa2,bf16x8 pa3){
  #pragma unroll
  for(int d0=0;d0<2;++d0){s16x4 lo[4],hi[4];
    #pragma unroll
    for(int ks=0;ks<4;++ks){
      asm volatile("ds_read_b64_tr_b16 %0,%1 offset:%c2":"=&v"(lo[ks]):"v"(vb),"i"(d0*4096+ks*1024):"memory");
      asm volatile("ds_read_b64_tr_b16 %0,%1 offset:%c2":"=&v"(hi[ks]):"v"(vb),"i"(d0*4096+ks*1024+512):"memory");}
    asm volatile("s_waitcnt lgkmcnt(0)":::"memory");SBAR();
    #define PK(k) (bf16x8){lo[k][0],lo[k][1],lo[k][2],lo[k][3],hi[k][0],hi[k][1],hi[k][2],hi[k][3]}
    o[d0]=__builtin_amdgcn_mfma_f32_32x32x16_bf16(pa0,PK(0),o[d0],0,0,0);
    o[d0]=__builtin_amdgcn_mfma_f32_32x32x16_bf16(pa1,PK(1),o[d0],0,0,0);
    o[d0]=__builtin_amdgcn_mfma_f32_32x32x16_bf16(pa2,PK(2),o[d0],0,0,0);
    o[d0]=__builtin_amdgcn_mfma_f32_32x32x16_bf16(pa3,PK(3),o[d0],0,0,0);
    #undef PK
  }
}

#ifndef ATTN_STORE16
#define ATTN_STORE16(p,v) (*(u32x4*)(p)=(v))
#endif
template<int THRL> __device__ __forceinline__ void attn_unit(const bf16*Qb,const bf16*__restrict__ Kh,const bf16*__restrict__ Vh,bf16*Ob,int opitch,int NT,char*shm){
  const int tid=opaque_tid(),lane=tid&63,r32=lane&31,hi=lane>>5; const int wid=__builtin_amdgcn_readfirstlane(tid>>6);
  const bf16*Qw=Qb+(long)(wid*QBLK)*DM;
  const unsigned lds0=(unsigned)(uintptr_t)shm;
  float*wsf=(float*)(shm+LDS_WS)+wid*64;
  const bf16*ksrc=Kh+(long)lane*DM+wid*8;
  const bf16*vsrc=Vh+(long)(16*(wid&3)+(lane>>2))*DM+(wid>>2)*32+(lane&3)*8;
  const unsigned kdst=lds0+LDS_K+wid*1024, vdst=lds0+LDS_V+wid*1024;
  #define DMA_K(t,slot) glds16(ksrc+(long)(t)*KVBLK*DM,(unsigned)__builtin_amdgcn_readfirstlane(kdst+(slot)))
  #define DMA_V(t,slot) glds16(vsrc+(long)(t)*KVBLK*DM,(unsigned)__builtin_amdgcn_readfirstlane(vdst+(slot)))
  const int vb0=(int)(lds0+LDS_V)+((lane>>4)&1)*32+(lane&3)*8+(4*hi+((lane&15)>>2))*64;
  const char*Kbase=shm+LDS_K; bf16x8 kf[8];
  const lds_cptr shm3=(lds_cptr)shm; const lds_cptr kp0=shm3+LDS_K+hi*1024+r32*16; const lds_cptr vp0=shm3+LDS_V+((lane>>4)&1)*32+(lane&3)*8+(4*hi+((lane&15)>>2))*64;
  DMA_K(0,0);DMA_V(0,0);DMA_K(1,SLOTB);
  bf16x8 qr[4];
  #pragma unroll
  for(int d0=0;d0<4;++d0)qr[d0]=*reinterpret_cast<const bf16x8*>(&Qw[(long)r32*DM+d0*16+hi*8]);
  float mhat=0.f,l_reg=0.f;f32x16 o[2];o[0]=f32x16{};o[1]=f32x16{};f32x16 negm=f32x16{};asm volatile("":"+v"(negm));
  #define CMASK(P0,P1,t) do{}while(0)
  bool resc=false;
  #define START(P0,P1) do{ const float rm=rowmax(P0,P1); resc=false; \
    { const float dl=rm; mhat=fadd_s(mhat,dl); \
      _Pragma("unroll") for(int r=0;r<16;++r){P0[r]=fsub_s(P0[r],dl);P1[r]=fsub_s(P1[r],dl);} \
      _Pragma("unroll") for(int r=0;r<16;++r)negm[r]=-mhat; asm volatile("":"+v"(negm)); } \
    _Pragma("unroll") for(int r=0;r<16;++r)P0[r]=__builtin_amdgcn_exp2f(P0[r]); }while(0)
  #define RESC() do{ if(resc){ asm volatile("s_waitcnt lgkmcnt(0)":::"memory"); \
      _Pragma("unroll") for(int d_=0;d_<2;++d_) _Pragma("unroll") for(int r=0;r<16;++r)o[d_][r]*=wsf[crow(r,hi)]; } }while(0)
  f32x16 pA0,pA1,pB0,pB1;
  int sl_prev=0,sl_cur=0,sl_next=SLOTB;
  #define ROT() do{sl_prev=sl_cur;sl_cur=sl_next;sl_next=(sl_next==(NSLOT-1)*SLOTB)?0:sl_next+SLOTB;}while(0)
  DMA_K(2,2*SLOTB);
  WAIT_BAR(3);
  qkt(pA0,pA1,Kbase,qr,negm,r32,hi);asm volatile("s_nop 15\n\ts_nop 7":"+v"(pA0),"+v"(pA1));CMASK(pA0,pA1,0);
  START(pA0,pA1);
  _Pragma("unroll") for(int r=0;r<16;++r)pA1[r]=__builtin_amdgcn_exp2f(pA1[r]);
  WAIT_BAR(0);
  DMA_K(3,0);DMA_V(1,SLOTB);
  ROT();
  kload8(kf,kp0+sl_cur);
  WAIT_BAR(2);
  s16x4 vlo[8],vhi[8]; u32x4 pw0,pw1,pw2,pw3;
  #define PKW(P,B) cvtpk_s(P[B],P[B+1])
  #define PAF(k) __builtin_bit_cast(bf16x8,pw##k)
  #define VFR(i) (bf16x8){vlo[i][0],vlo[i][1],vlo[i][2],vlo[i][3],vhi[i][0],vhi[i][1],vhi[i][2],vhi[i][3]}
  #define PIN(x) asm volatile("":"+v"(x))
  #define MX3(a,b,c) __builtin_fmaxf(__builtin_fmaxf((a),(b)),(c))
  #define GAPA(MF,A0,A1,A2,A3,W0,W1,PW) do{ MF; sacc+=A0; sacc+=A1; sacc+=A2; sacc+=A3; PIN(sacc); W0; W1; PIN(PW); SBAR(); }while(0)
  #define EX(v) __builtin_amdgcn_exp2f(v)
  #define GAPB(MF,X,B) do{ MF; X[B]=EX(X[B]); X[B+1]=EX(X[B+1]); X[B+2]=EX(X[B+2]); X[B+3]=EX(X[B+3]); PIN(X); SBAR(); }while(0)
  #define VRD(i) do{ vlo[i]=vtr(vp_+(((i)>>2)*4096+((i)&3)*1024)); vhi[i]=vtr(vp_+(((i)>>2)*4096+((i)&3)*1024+512)); }while(0)
  #define KRD(G,j) do{ if(G){ kload2(kf,kp0+sl_next,j); SBAR(); } }while(0)
  #define STEP(C0,C1,P0,P1,t,GK,GV,GL) do{ SBAR(); \
    const lds_cptr vp_=vp0+sl_prev; \
    VRD(0); SBAR(); float sacc=(P0[0]+P0[1]); \
    GAPA(C0=__builtin_amdgcn_mfma_f32_32x32x16_bf16(kf[0],qr[0],negm,0,0,0), P0[2],P0[3],P0[4],P0[5],     pw0[0]=PKW(P0,0), pw0[1]=PKW(P0,2), pw0); \
    VRD(4); SBAR(); GAPA(C1=__builtin_amdgcn_mfma_f32_32x32x16_bf16(kf[1],qr[0],negm,0,0,0), P0[6],P0[7],P0[8],P0[9],     pw0[2]=PKW(P0,4), pw0[3]=PKW(P0,6), pw0); \
    VRD(1); SBAR(); GAPA(C0=__builtin_amdgcn_mfma_f32_32x32x16_bf16(kf[2],qr[1],C0,0,0,0),   P0[10],P0[11],P0[12],P0[13], pw1[0]=PKW(P0,8), pw1[1]=PKW(P0,10), pw1); \
    VRD(5); SBAR(); GAPA(C1=__builtin_amdgcn_mfma_f32_32x32x16_bf16(kf[3],qr[1],C1,0,0,0),   P0[14],P0[15],P1[0],P1[1],   pw1[2]=PKW(P0,12),pw1[3]=PKW(P0,14), pw1); \
    VRD(2); SBAR(); GAPA(C0=__builtin_amdgcn_mfma_f32_32x32x16_bf16(kf[4],qr[2],C0,0,0,0),   P1[2],P1[3],P1[4],P1[5],     pw2[0]=PKW(P1,0), pw2[1]=PKW(P1,2), pw2); \
    VRD(6); SBAR(); GAPA(C1=__builtin_amdgcn_mfma_f32_32x32x16_bf16(kf[5],qr[2],C1,0,0,0),   P1[6],P1[7],P1[8],P1[9],     pw2[2]=PKW(P1,4), pw2[3]=PKW(P1,6), pw2); \
    VRD(3); SBAR(); GAPA(C0=__builtin_amdgcn_mfma_f32_32x32x16_bf16(kf[6],qr[3],C0,0,0,0),   P1[10],P1[11],P1[12],P1[13], pw3[0]=PKW(P1,8), pw3[1]=PKW(P1,10), pw3); \
    VRD(7); SBAR(); GAPA(C1=__builtin_amdgcn_mfma_f32_32x32x16_bf16(kf[7],qr[3],C1,0,0,0),   P1[14],P1[15],0.f,0.f,       pw3[2]=PKW(P1,12),pw3[3]=PKW(P1,14), pw3); \
    l_reg+=sacc; \
    if(GK){DMA_K((t)+3,sl_cur);} if(GV){DMA_V((t)+1,sl_next);} \
    CMASK(C0,C1,t); \
    { float a=MX3(C0[0],C0[1],C1[0]),b=MX3(C0[2],C0[3],C1[1]); a=MX3(a,C1[2],C1[3]); \
      _Pragma("unroll") for(int r=4;r<16;r+=4){a=MX3(a,C0[r],C0[r+1]);b=MX3(b,C0[r+2],C0[r+3]);a=MX3(a,C1[r],C1[r+1]);b=MX3(b,C1[r+2],C1[r+3]);} \
      float rm=__builtin_fmaxf(a,b); { auto rr=__builtin_amdgcn_permlane32_swap(__float_as_uint(rm),__float_as_uint(rm),false,false); rm=__builtin_fmaxf(__uint_as_float(rr[0]),__uint_as_float(rr[1])); } \
      resc=false; \
      if(__builtin_expect(__any(rm>(float)THRL),0)){ const float dl=__builtin_fmaxf(rm,0.f); mhat+=dl; \
        _Pragma("unroll") for(int r=0;r<16;++r){C0[r]-=dl;C1[r]-=dl;} \
        _Pragma("unroll") for(int r=0;r<16;++r)negm[r]=-mhat; asm volatile("":"+v"(negm)); \
        const float f=__builtin_amdgcn_exp2f(-dl); l_reg*=f; if(hi==0)wsf[r32]=f; resc=true; } } \
    SBAR(); \
    GAPB(o[0]=__builtin_amdgcn_mfma_f32_32x32x16_bf16(PAF(0),VFR(0),o[0],0,0,0), C0,0); \
    GAPB(o[1]=__builtin_amdgcn_mfma_f32_32x32x16_bf16(PAF(0),VFR(4),o[1],0,0,0), C0,4); \
    KRD(GL,0); GAPB(o[0]=__builtin_amdgcn_mfma_f32_32x32x16_bf16(PAF(1),VFR(1),o[0],0,0,0), C0,8); \
    KRD(GL,1); GAPB(o[1]=__builtin_amdgcn_mfma_f32_32x32x16_bf16(PAF(1),VFR(5),o[1],0,0,0), C0,12); \
    KRD(GL,2); GAPB(o[0]=__builtin_amdgcn_mfma_f32_32x32x16_bf16(PAF(2),VFR(2),o[0],0,0,0), C1,0); \
    KRD(GL,3); GAPB(o[1]=__builtin_amdgcn_mfma_f32_32x32x16_bf16(PAF(2),VFR(6),o[1],0,0,0), C1,4); \
    GAPB(o[0]=__builtin_amdgcn_mfma_f32_32x32x16_bf16(PAF(3),VFR(3),o[0],0,0,0), C1,8); \
    GAPB(o[1]=__builtin_amdgcn_mfma_f32_32x32x16_bf16(PAF(3),VFR(7),o[1],0,0,0), C1,12); \
    }while(0)
  if(wid>=4)__builtin_amdgcn_s_setprio(1);
  int t=1;
  #undef CMASK
  #define CMASK(P0,P1,t) do{}while(0)
  for(;t+5<NT;t+=2){
    STEP(pB0,pB1,pA0,pA1,t,true,true,true);     WAIT_BAR(2); RESC(); ROT();
    STEP(pA0,pA1,pB0,pB1,t+1,true,true,true);   WAIT_BAR(2); RESC(); ROT();
  }
  #undef CMASK
  #define CMASK(P0,P1,t) do{}while(0)
  #define ENDW(tt) do{ if((tt)+3<NT){WAIT_BAR(2);} else if((tt)+2<NT){WAIT_BAR(1);} else {WAIT_BAR(0);} }while(0)
  for(;t+1<NT;t+=2){
    STEP(pB0,pB1,pA0,pA1,t,(t+3<NT),(t+1<NT),(t+1<NT));       ENDW(t);   RESC(); ROT();
    STEP(pA0,pA1,pB0,pB1,t+1,(t+4<NT),(t+2<NT),(t+2<NT));     ENDW(t+1); RESC(); ROT();
  }
  STEP(pB0,pB1,pA0,pA1,NT-1,false,false,false); RESC();
  { float sacc=pB0[0]+pB0[1]; _Pragma("unroll") for(int r=2;r<16;++r)sacc+=pB0[r]; _Pragma("unroll") for(int r=0;r<16;++r)sacc+=pB1[r]; l_reg+=sacc;
    pw0=(u32x4){PKW(pB0,0),PKW(pB0,2),PKW(pB0,4),PKW(pB0,6)};pw1=(u32x4){PKW(pB0,8),PKW(pB0,10),PKW(pB0,12),PKW(pB0,14)};pw2=(u32x4){PKW(pB1,0),PKW(pB1,2),PKW(pB1,4),PKW(pB1,6)};pw3=(u32x4){PKW(pB1,8),PKW(pB1,10),PKW(pB1,12),PKW(pB1,14)};
    SBAR(); pv(o,vb0+sl_cur,PAF(0),PAF(1),PAF(2),PAF(3)); }
  #undef PKW
  #undef PAF
  #undef VFR
  #undef PIN
  #undef MX3
  #undef GAPA
  #undef GAPB
  #undef EX
  #undef VRD
  #undef KRD
  #undef STEP
  #undef ENDW
  __builtin_amdgcn_s_setprio(0);
  {auto rr=__builtin_amdgcn_permlane32_swap(__float_as_uint(l_reg),__float_as_uint(l_reg),false,false);l_reg=__uint_as_float(rr[0])+__uint_as_float(rr[1]);}
  if(hi==0)wsf[32+r32]=l_reg;asm volatile("s_waitcnt lgkmcnt(0)":::"memory");
  float rli[16];
  #pragma unroll
  for(int r=0;r<16;++r)rli[r]=__builtin_amdgcn_rcpf(wsf[32+crow(r,hi)]);
  bf16*Ow=Ob+(long)(wid*QBLK)*opitch;
  { bf16*stg=(bf16*)(shm+LDS_OST)+wid*2048;
    #pragma unroll
    for(int r=0;r<16;++r){const int orow=crow(r,hi);
      #pragma unroll
      for(int d0=0;d0<2;++d0)stg[orow*64+d0*32+r32]=__float2bfloat16(o[d0][r]*rli[r]);}
    asm volatile("s_waitcnt lgkmcnt(0)":::"memory");
    #pragma unroll
    for(int i=0;i<4;++i){const int row=i*8+(lane>>3),ch=lane&7; const u32x4 v=*(const u32x4*)(stg+row*64+ch*8); ATTN_STORE16(Ow+(long)row*opitch+ch*8,v);} }
  asm volatile("s_waitcnt lgkmcnt(0)\n\ts_barrier":::"memory");
  #undef DMA_K
  #undef DMA_V
  #undef CMASK
  #undef START
  #undef RESC
  #undef ROT
}
__device__ __forceinline__ void pv128(f32x16*o,int vb,bf16x8 pa0,bf16x8 pa1,bf16x8 pa2,bf16x8 pa3){
  #pragma unroll
  for(int d0=0;d0<4;++d0){s16x4 lo[4],hi[4];
    #pragma unroll
    for(int ks=0;ks<4;++ks){
      asm volatile("ds_read_b64_tr_b16 %0,%1 offset:%c2":"=&v"(lo[ks]):"v"(vb),"i"(d0*4096+ks*1024):"memory");
      asm volatile("ds_read_b64_tr_b16 %0,%1 offset:%c2":"=&v"(hi[ks]):"v"(vb),"i"(d0*4096+ks*1024+512):"memory");}
    asm volatile("s_waitcnt lgkmcnt(0)":::"memory");SBAR();
    #define PK(k) (bf16x8){lo[k][0],lo[k][1],lo[k][2],lo[k][3],hi[k][0],hi[k][1],hi[k][2],hi[k][3]}
    o[d0]=__builtin_amdgcn_mfma_f32_32x32x16_bf16(pa0,PK(0),o[d0],0,0,0);
    o[d0]=__builtin_amdgcn_mfma_f32_32x32x16_bf16(pa1,PK(1),o[d0],0,0,0);
    o[d0]=__builtin_amdgcn_mfma_f32_32x32x16_bf16(pa2,PK(2),o[d0],0,0,0);
    o[d0]=__builtin_amdgcn_mfma_f32_32x32x16_bf16(pa3,PK(3),o[d0],0,0,0);
    #undef PK
  }
}
constexpr int LDS_WS128=LDS_V+NSLOT*16384, LDS_OST128=LDS_WS128+NW*64*4, LDS_BYTES128=LDS_OST128+NW*8192;
template<int THRL> __device__ __forceinline__ void attn_unit128(const bf16*Qb,const bf16*__restrict__ Kh,const bf16*__restrict__ Vh,bf16*Ob,int opitch,int NT,char*shm){
  const int tid=opaque_tid(),lane=tid&63,r32=lane&31,hi=lane>>5; const int wid=__builtin_amdgcn_readfirstlane(tid>>6);
  const bf16*Qw=Qb+(long)(wid*QBLK)*DM;
  const unsigned lds0=(unsigned)(uintptr_t)shm;
  float*wsf=(float*)(shm+LDS_WS128)+wid*64;
  const bf16*ksrc=Kh+(long)lane*DM+wid*8;
  const bf16*vsrc=Vh+(long)(16*(wid&3)+(lane>>2))*DM+(wid>>2)*32+(lane&3)*8;
  const unsigned kdst=lds0+LDS_K+wid*1024, vdst=lds0+LDS_V+wid*1024;
  #define DMA_K(t,slot) glds16(ksrc+(long)(t)*KVBLK*DM,(unsigned)__builtin_amdgcn_readfirstlane(kdst+(slot)))
  #define DMA_V(t,slot) do{ glds16(vsrc+(long)(t)*KVBLK*DM,(unsigned)__builtin_amdgcn_readfirstlane(vdst+2*(slot))); glds16(vsrc+64+(long)(t)*KVBLK*DM,(unsigned)__builtin_amdgcn_readfirstlane(vdst+2*(slot)+8192)); }while(0)
  const int vb0=(int)(lds0+LDS_V)+((lane>>4)&1)*32+(lane&3)*8+(4*hi+((lane&15)>>2))*64;
  const char*Kbase=shm+LDS_K; bf16x8 kf[8];
  const lds_cptr shm3=(lds_cptr)shm; const lds_cptr kp0=shm3+LDS_K+hi*1024+r32*16; const lds_cptr vp0=shm3+LDS_V+((lane>>4)&1)*32+(lane&3)*8+(4*hi+((lane&15)>>2))*64;
  DMA_K(0,0);DMA_V(0,0);DMA_K(1,SLOTB);
  bf16x8 qr[4];
  #pragma unroll
  for(int d0=0;d0<4;++d0)qr[d0]=*reinterpret_cast<const bf16x8*>(&Qw[(long)r32*DM+d0*16+hi*8]);
  float mhat=0.f,l_reg=0.f;f32x16 o[4];o[0]=f32x16{};o[1]=f32x16{};o[2]=f32x16{};o[3]=f32x16{};float negmf=0.f; const f32x16 zero16=f32x16{};
  #define CMASK(P0,P1,t) do{}while(0)
  bool resc=false;
  #define START(P0,P1) do{ const float rm=rowmax(P0,P1); resc=false; \
    { const float dl=rm; mhat=fadd_s(mhat,dl); \
      _Pragma("unroll") for(int r=0;r<16;++r){P0[r]=fsub_s(P0[r],dl);P1[r]=fsub_s(P1[r],dl);} \
      negmf=-mhat; } \
    _Pragma("unroll") for(int r=0;r<16;++r)P0[r]=__builtin_amdgcn_exp2f(P0[r]); }while(0)
  #define RESC() do{ if(resc){ asm volatile("s_waitcnt lgkmcnt(0)":::"memory"); \
      _Pragma("unroll") for(int d_=0;d_<4;++d_) _Pragma("unroll") for(int r=0;r<16;++r)o[d_][r]*=wsf[crow(r,hi)]; } }while(0)
  f32x16 pA0,pA1,pB0,pB1;
  int sl_prev=0,sl_cur=0,sl_next=SLOTB;
  #define ROT() do{sl_prev=sl_cur;sl_cur=sl_next;sl_next=(sl_next==(NSLOT-1)*SLOTB)?0:sl_next+SLOTB;}while(0)
  DMA_K(2,2*SLOTB);
  WAIT_BAR(3);
  qkt(pA0,pA1,Kbase,qr,zero16,r32,hi);asm volatile("s_nop 15\n\ts_nop 7":"+v"(pA0),"+v"(pA1));CMASK(pA0,pA1,0);
  START(pA0,pA1);
  _Pragma("unroll") for(int r=0;r<16;++r)pA1[r]=__builtin_amdgcn_exp2f(pA1[r]);
  WAIT_BAR(0);
  DMA_K(3,0);DMA_V(1,SLOTB);
  ROT();
  kload8(kf,kp0+sl_cur);
  WAIT_BAR(3);
  s16x4 vlo[4],vhi[4]; u32x4 pw0,pw1,pw2,pw3;
  #define PKW(P,B) cvtpk_s(P[B],P[B+1])
  #define PAF(k) __builtin_bit_cast(bf16x8,pw##k)
  #define VFR(i) (bf16x8){vlo[i][0],vlo[i][1],vlo[i][2],vlo[i][3],vhi[i][0],vhi[i][1],vhi[i][2],vhi[i][3]}
  #define PIN(x) asm volatile("":"+v"(x))
  #define MX3(a,b,c) __builtin_fmaxf(__builtin_fmaxf((a),(b)),(c))
  #define GAPA(MF,A0,A1,A2,A3,W0,W1,PW) do{ MF; sacc+=A0; sacc+=A1; sacc+=A2; sacc+=A3; PIN(sacc); W0; W1; PIN(PW); SBAR(); }while(0)
  #define EX(v) __builtin_amdgcn_exp2f(v)
  #define GAPB(MF,X,B) do{ MF; X[B]=EX(X[B]); X[B+1]=EX(X[B+1]); X[B+2]=EX(X[B+2]); X[B+3]=EX(X[B+3]); PIN(X); SBAR(); }while(0)
  #define GAPB2(MF,X,B) do{ MF; X[B]=EX(X[B]); X[B+1]=EX(X[B+1]); PIN(X); SBAR(); }while(0)
  #define VRDX(reg,fr) do{ vlo[reg]=vtr(vp_+(((fr)>>2)*4096+((fr)&3)*1024)); vhi[reg]=vtr(vp_+(((fr)>>2)*4096+((fr)&3)*1024+512)); }while(0)
  #define VRD(i) do{ vlo[i]=vtr(vp_+(((i)>>2)*4096+((i)&3)*1024)); vhi[i]=vtr(vp_+(((i)>>2)*4096+((i)&3)*1024+512)); }while(0)
  #define KRD(G,j) do{ if(G){ kload2(kf,kp0+sl_next,j); SBAR(); } }while(0)
  #define STEP(C0,C1,P0,P1,t,GK,GV,GL) do{ SBAR(); \
    const lds_cptr vp_=vp0+2*sl_prev; \
    VRDX(0,0); SBAR(); float sacc=(P0[0]+P0[1]); \
    GAPA(C0=__builtin_amdgcn_mfma_f32_32x32x16_bf16(kf[0],qr[0],zero16,0,0,0), P0[2],P0[3],P0[4],P0[5],     pw0[0]=PKW(P0,0), pw0[1]=PKW(P0,2), pw0); \
    VRDX(1,4); SBAR(); GAPA(C1=__builtin_amdgcn_mfma_f32_32x32x16_bf16(kf[1],qr[0],zero16,0,0,0), P0[6],P0[7],P0[8],P0[9],     pw0[2]=PKW(P0,4), pw0[3]=PKW(P0,6), pw0); \
    VRDX(2,1); SBAR(); GAPA(C0=__builtin_amdgcn_mfma_f32_32x32x16_bf16(kf[2],qr[1],C0,0,0,0),   P0[10],P0[11],P0[12],P0[13], pw1[0]=PKW(P0,8), pw1[1]=PKW(P0,10), pw1); \
    VRDX(3,5); SBAR(); GAPA(C1=__builtin_amdgcn_mfma_f32_32x32x16_bf16(kf[3],qr[1],C1,0,0,0),   P0[14],P0[15],P1[0],P1[1],   pw1[2]=PKW(P0,12),pw1[3]=PKW(P0,14), pw1); \
    GAPA(C0=__builtin_amdgcn_mfma_f32_32x32x16_bf16(kf[4],qr[2],C0,0,0,0),   P1[2],P1[3],P1[4],P1[5],     pw2[0]=PKW(P1,0), pw2[1]=PKW(P1,2), pw2); \
    GAPA(C1=__builtin_amdgcn_mfma_f32_32x32x16_bf16(kf[5],qr[2],C1,0,0,0),   P1[6],P1[7],P1[8],P1[9],     pw2[2]=PKW(P1,4), pw2[3]=PKW(P1,6), pw2); \
    GAPA(C0=__builtin_amdgcn_mfma_f32_32x32x16_bf16(kf[6],qr[3],C0,0,0,0),   P1[10],P1[11],P1[12],P1[13], pw3[0]=PKW(P1,8), pw3[1]=PKW(P1,10), pw3); \
    GAPA(C1=__builtin_amdgcn_mfma_f32_32x32x16_bf16(kf[7],qr[3],C1,0,0,0),   P1[14],P1[15],0.f,0.f,       pw3[2]=PKW(P1,12),pw3[3]=PKW(P1,14), pw3); \
    l_reg+=sacc; \
    if(GK){DMA_K((t)+3,sl_cur);} if(GV){DMA_V((t)+1,sl_next);} \
    _Pragma("unroll") for(int r=0;r<16;++r){C0[r]+=negmf;C1[r]+=negmf;} \
    { float a=MX3(C0[0],C0[1],C1[0]),b=MX3(C0[2],C0[3],C1[1]); a=MX3(a,C1[2],C1[3]); \
      _Pragma("unroll") for(int r=4;r<16;r+=4){a=MX3(a,C0[r],C0[r+1]);b=MX3(b,C0[r+2],C0[r+3]);a=MX3(a,C1[r],C1[r+1]);b=MX3(b,C1[r+2],C1[r+3]);} \
      float rm=__builtin_fmaxf(a,b); { auto rr=__builtin_amdgcn_permlane32_swap(__float_as_uint(rm),__float_as_uint(rm),false,false); rm=__builtin_fmaxf(__uint_as_float(rr[0]),__uint_as_float(rr[1])); } \
      resc=false; \
      if(__builtin_expect(__any(rm>(float)THRL),0)){ const float dl=__builtin_fmaxf(rm,0.f); mhat+=dl; \
        _Pragma("unroll") for(int r=0;r<16;++r){C0[r]-=dl;C1[r]-=dl;} \
        negmf=-mhat; \
        const float f=__builtin_amdgcn_exp2f(-dl); l_reg*=f; if(hi==0)wsf[r32]=f; resc=true; } } \
    SBAR(); \
    GAPB2(o[0]=__builtin_amdgcn_mfma_f32_32x32x16_bf16(PAF(0),VFR(0),o[0],0,0,0), C0,0); VRDX(0,2); SBAR(); \
    GAPB2(o[1]=__builtin_amdgcn_mfma_f32_32x32x16_bf16(PAF(0),VFR(1),o[1],0,0,0), C0,2); VRDX(1,6); SBAR(); \
    KRD(GL,0); GAPB2(o[0]=__builtin_amdgcn_mfma_f32_32x32x16_bf16(PAF(1),VFR(2),o[0],0,0,0), C0,4); VRDX(2,3); SBAR(); \
    KRD(GL,1); GAPB2(o[1]=__builtin_amdgcn_mfma_f32_32x32x16_bf16(PAF(1),VFR(3),o[1],0,0,0), C0,6); VRDX(3,7); SBAR(); \
    KRD(GL,2); GAPB2(o[0]=__builtin_amdgcn_mfma_f32_32x32x16_bf16(PAF(2),VFR(0),o[0],0,0,0), C0,8); VRDX(0,8); SBAR(); \
    KRD(GL,3); GAPB2(o[1]=__builtin_amdgcn_mfma_f32_32x32x16_bf16(PAF(2),VFR(1),o[1],0,0,0), C0,10); VRDX(1,12); SBAR(); \
    GAPB2(o[0]=__builtin_amdgcn_mfma_f32_32x32x16_bf16(PAF(3),VFR(2),o[0],0,0,0), C0,12); VRDX(2,9); SBAR(); \
    GAPB2(o[1]=__builtin_amdgcn_mfma_f32_32x32x16_bf16(PAF(3),VFR(3),o[1],0,0,0), C0,14); VRDX(3,13); SBAR(); \
    GAPB2(o[2]=__builtin_amdgcn_mfma_f32_32x32x16_bf16(PAF(0),VFR(0),o[2],0,0,0), C1,0); VRDX(0,10); SBAR(); \
    GAPB2(o[3]=__builtin_amdgcn_mfma_f32_32x32x16_bf16(PAF(0),VFR(1),o[3],0,0,0), C1,2); VRDX(1,14); SBAR(); \
    GAPB2(o[2]=__builtin_amdgcn_mfma_f32_32x32x16_bf16(PAF(1),VFR(2),o[2],0,0,0), C1,4); VRDX(2,11); SBAR(); \
    GAPB2(o[3]=__builtin_amdgcn_mfma_f32_32x32x16_bf16(PAF(1),VFR(3),o[3],0,0,0), C1,6); VRDX(3,15); SBAR(); \
    GAPB2(o[2]=__builtin_amdgcn_mfma_f32_32x32x16_bf16(PAF(2),VFR(0),o[2],0,0,0), C1,8); \
    GAPB2(o[3]=__builtin_amdgcn_mfma_f32_32x32x16_bf16(PAF(2),VFR(1),o[3],0,0,0), C1,10); \
    GAPB2(o[2]=__builtin_amdgcn_mfma_f32_32x32x16_bf16(PAF(3),VFR(2),o[2],0,0,0), C1,12); \
    GAPB2(o[3]=__builtin_amdgcn_mfma_f32_32x32x16_bf16(PAF(3),VFR(3),o[3],0,0,0), C1,14); \
    }while(0)
  if(wid>=4)__builtin_amdgcn_s_setprio(1);
  int t=1;
  #undef CMASK
  #define CMASK(P0,P1,t) do{}while(0)
  for(;t+5<NT;t+=2){
    STEP(pB0,pB1,pA0,pA1,t,true,true,true);     WAIT_BAR(3); RESC(); ROT();
    STEP(pA0,pA1,pB0,pB1,t+1,true,true,true);   WAIT_BAR(3); RESC(); ROT();
  }
  #undef CMASK
  #define CMASK(P0,P1,t) do{}while(0)
  #define ENDW(tt) do{ if((tt)+3<NT){WAIT_BAR(3);} else if((tt)+2<NT){WAIT_BAR(2);} else {WAIT_BAR(0);} }while(0)
  for(;t+1<NT;t+=2){
    STEP(pB0,pB1,pA0,pA1,t,(t+3<NT),(t+1<NT),(t+1<NT));       ENDW(t);   RESC(); ROT();
    STEP(pA0,pA1,pB0,pB1,t+1,(t+4<NT),(t+2<NT),(t+2<NT));     ENDW(t+1); RESC(); ROT();
  }
  STEP(pB0,pB1,pA0,pA1,NT-1,false,false,false); RESC();
  { float sacc=pB0[0]+pB0[1]; _Pragma("unroll") for(int r=2;r<16;++r)sacc+=pB0[r]; _Pragma("unroll") for(int r=0;r<16;++r)sacc+=pB1[r]; l_reg+=sacc;
    pw0=(u32x4){PKW(pB0,0),PKW(pB0,2),PKW(pB0,4),PKW(pB0,6)};pw1=(u32x4){PKW(pB0,8),PKW(pB0,10),PKW(pB0,12),PKW(pB0,14)};pw2=(u32x4){PKW(pB1,0),PKW(pB1,2),PKW(pB1,4),PKW(pB1,6)};pw3=(u32x4){PKW(pB1,8),PKW(pB1,10),PKW(pB1,12),PKW(pB1,14)};
    SBAR(); pv128(o,vb0+2*sl_cur,PAF(0),PAF(1),PAF(2),PAF(3)); }
  #undef PKW
  #undef PAF
  #undef VFR
  #undef PIN
  #undef MX3
  #undef GAPA
  #undef GAPB
  #undef EX
  #undef VRD
  #undef VRDX
  #undef GAPB2
  #undef KRD
  #undef STEP
  #undef ENDW
  __builtin_amdgcn_s_setprio(0);
  {auto rr=__builtin_amdgcn_permlane32_swap(__float_as_uint(l_reg),__float_as_uint(l_reg),false,false);l_reg=__uint_as_float(rr[0])+__uint_as_float(rr[1]);}
  if(hi==0)wsf[32+r32]=l_reg;asm volatile("s_waitcnt lgkmcnt(0)":::"memory");
  float rli[16];
  #pragma unroll
  for(int r=0;r<16;++r)rli[r]=__builtin_amdgcn_rcpf(wsf[32+crow(r,hi)]);
  bf16*Ow=Ob+(long)(wid*QBLK)*opitch;
  { bf16*stg=(bf16*)(shm+LDS_OST128)+wid*4096;
    #pragma unroll
    for(int r=0;r<16;++r){const int orow=crow(r,hi);
      #pragma unroll
      for(int d0=0;d0<4;++d0)stg[orow*128+d0*32+r32]=__float2bfloat16(o[d0][r]*rli[r]);}
    asm volatile("s_waitcnt lgkmcnt(0)":::"memory");
    #pragma unroll
    for(int i=0;i<8;++i){const int row=i*4+(lane>>4),ch=lane&15; const u32x4 v=*(const u32x4*)(stg+row*128+ch*8); ATTN_STORE16(Ow+(long)row*opitch+ch*8,v);} }
  asm volatile("s_waitcnt lgkmcnt(0)\n\ts_barrier":::"memory");
  #undef DMA_K
  #undef DMA_V
  #undef CMASK
  #undef START
  #undef RESC
  #undef ROT
}
constexpr int ATTN_LDS_BYTES=LDS_BYTES128;
#undef SBAR
#undef WAIT_BAR
}
__device__ __forceinline__ int prow_std(int c) { const int t = c & 255; return (c & ~255) + ((t >> 5) & 1) * 128 + (t >> 6) * 32 + ((t >> 2) & 1) * 16 + ((t >> 3) & 3) * 4 + (t & 3); }
__device__ __forceinline__ int prow_gu(int f, int isup) { const int c = f & 127; return (f >> 7) * 256 + isup * 128 + (c >> 5) * 32 + ((c >> 2) & 1) * 16 + ((c >> 3) & 3) * 4 + (c & 3); }

struct TrDesc { const float* src; bf16_t* dst; int ldw, ldt, nl0, mode, nper; };
__device__ __forceinline__ void tr_load(const TrDesc& d, f32x4 (&a)[8], f32x4 (&b)[8], int lane) {
    const int nc = lane & 15, kr = lane >> 4;
#pragma unroll
    for (int it = 0; it < 8; ++it) { const int kp = kr + 4 * it;
        a[it] = __builtin_nontemporal_load((const f32x4*)(d.src + (size_t)(2 * kp) * d.ldw + 4 * nc)); b[it] = __builtin_nontemporal_load((const f32x4*)(d.src + (size_t)(2 * kp + 1) * d.ldw + 4 * nc)); }
}
__device__ __forceinline__ void tr_process(const TrDesc& d, const f32x4 (&a)[8], const f32x4 (&b)[8], LAS unsigned* scr, int lane) {
    const int nc = lane & 15, kr = lane >> 4;
#pragma unroll
    for (int it = 0; it < 8; ++it) { const int kp = kr + 4 * it;
#pragma unroll
        for (int i = 0; i < 4; ++i) scr[(4 * nc + i) * 66 + kp] = cvtpk(a[it][i], b[it][i]); }
    LDS_WAIT();
#pragma unroll
    for (int it = 0; it < 8; ++it) {
        const int n = (lane >> 3) + 8 * it, c = lane & 7;
        const LAS u32x2* s = (const LAS u32x2*)(scr + n * 66 + 4 * c);
        const u32x2 lo = s[0], hi = s[1];
        const int cl = d.nl0 + n;
        const int pr = (d.mode == 0) ? prow_std(cl) : prow_gu(cl, d.mode - 1);
        *(u32x4*)(d.dst + (size_t)pr * d.ldt + 8 * c) = (u32x4){lo.x, lo.y, hi.x, hi.y};
    }
    LDS_WAIT();
}
#define GAS __attribute__((address_space(1)))
struct TrLane { const GAS float* s; GAS bf16_t* t; int ldw, ldt, nb, nper, mode; };
__device__ __forceinline__ TrLane tr_lane(const TrDesc& d, int lane) {
    TrLane L; const bool f8 = d.mode != 0;
    L.s = (const GAS float*)d.src - d.nl0 + (size_t)((f8 ? 4 : 2) * (lane >> 4)) * d.ldw + 4 * (lane & 15);
    L.t = f8 ? (GAS bf16_t*)((GAS unsigned char*)d.dst + 16 * (lane & 3)) : (GAS bf16_t*)d.dst + 8 * (lane & 7); L.ldw = d.ldw; L.ldt = d.ldt; L.nb = d.nl0 >> 6;
    L.nper = d.nper; L.mode = d.mode;
    asm volatile("" : "+v"(L.s), "+v"(L.t), "+v"(L.ldw), "+v"(L.ldt), "+v"(L.nb), "+v"(L.nper), "+v"(L.mode));
    return L;
}
__device__ __forceinline__ void tr_adv(TrLane& L) { const bool w = (L.nb + 1 == L.nper); L.nb = w ? 0 : L.nb + 1; L.s += w ? (size_t)64 * L.ldw : (size_t)0; L.t += w ? ((L.mode != 0) ? 32 : 64) : 0; }
__device__ __forceinline__ void tr_load_l(const TrLane& L, f32x4 (&a)[8], f32x4 (&b)[8]) {
    const int sc = L.nb * 64;
    const bool f8 = L.mode != 0;
#pragma unroll
    for (int it = 0; it < 8; ++it) { const int ro = f8 ? 16 * (it >> 1) + 2 * (it & 1) : 8 * it; const GAS float* r = L.s + (size_t)ro * L.ldw + sc;
        a[it] = __builtin_nontemporal_load((const GAS f32x4*)r); b[it] = __builtin_nontemporal_load((const GAS f32x4*)(r + L.ldw)); }
}
__device__ __forceinline__ void tr_process_l(const TrLane& L, const f32x4 (&a)[8], const f32x4 (&b)[8], LAS unsigned* scr, int lane) {
    const int nc = lane & 15, kr = lane >> 4;
    if (L.mode != 0) {
#pragma unroll
        for (int t = 0; t < 4; ++t)
#pragma unroll
            for (int i = 0; i < 4; ++i) scr[(4 * nc + i) * 20 + kr + 4 * t] = cvt4_fp8_nc(a[2 * t][i] * F8_WSCALE, b[2 * t][i] * F8_WSCALE, a[2 * t + 1][i] * F8_WSCALE, b[2 * t + 1][i] * F8_WSCALE);
        LDS_WAIT();
#pragma unroll
        for (int it = 0; it < 4; ++it) {
            const int n = (lane >> 2) + 16 * it, c4 = lane & 3;
            const u32x4 v = *(const LAS u32x4*)(scr + n * 20 + 4 * c4);
            const int cl = L.nb * 64 + n;
            const int pr = (L.mode == 3) ? prow_std(cl) : prow_gu(cl, L.mode - 1);
            *(GAS u32x4*)((GAS unsigned char*)L.t + (size_t)pr * L.ldt) = v;
        }
        LDS_WAIT();
        return;
    }
#pragma unroll
    for (int it = 0; it < 8; ++it) { const int kp = kr + 4 * it;
#pragma unroll
        for (int i = 0; i < 4; ++i) scr[(4 * nc + i) * 66 + kp] = cvtpk(a[it][i], b[it][i]); }
    LDS_WAIT();
#pragma unroll
    for (int it = 0; it < 8; ++it) {
        const int n = (lane >> 3) + 8 * it, c = lane & 7;
        const LAS u32x2* sp = (const LAS u32x2*)(scr + n * 66 + 4 * c);
        const u32x2 lo = sp[0], hi = sp[1];
        const int cl = L.nb * 64 + n;
        *(GAS u32x4*)(L.t + (size_t)prow_std(cl) * L.ldt) = (u32x4){lo.x, lo.y, hi.x, hi.y};
    }
    LDS_WAIT();
}
constexpr int TR_I_INB = 16 * 68, TR_I_GT = 16 * 48, TR_I_IN = TR_I_INB + TR_I_GT, TR_I_BR = 8 * 16, TR_I_OUT = 16 * 16, TR_I_G = 16 * 32, TR_I_D = 32 * 16;
constexpr int TR_I_NONEXP = TR_I_IN + 3 * TR_I_BR + TR_I_OUT;
constexpr int TR_I_EXP = 2 * TR_I_G + TR_I_D;
constexpr int TR_PRO_ITEMS = TR_I_NONEXP;
constexpr int TR_BG_L0GU = NE * 2 * TR_I_G;
constexpr int TR_BG_L0 = NE * TR_I_EXP;
constexpr int TR_BG_ITEMS = 2 * NE * TR_I_EXP;
__device__ __forceinline__ TrDesc tr_decode_dense(const Params& p, int l, int r) {
    unsigned char* ws = p.ws; TrDesc d;
    if (r < TR_I_INB) { const int kb = r / 68, nb = r % 68, nl0 = nb * 64;
        d.src = p.w_in + (size_t)l * 1024 * INCOLS + (size_t)kb * 64 * INCOLS + nl0; d.ldw = INCOLS; d.dst = (bf16_t*)(ws + WS_WIN) + (size_t)l * NPROJ * 1024 + kb * 64; d.ldt = 1024; d.nl0 = nl0; d.mode = 0; d.nper = 68; return d; }
    r -= TR_I_INB;
    if (r < TR_I_GT) { const int kb = r / 48, nb = r % 48, nl0 = nb * 64;
        d.src = p.w_in + (size_t)l * 1024 * INCOLS + (size_t)kb * 64 * INCOLS + 4368 + nl0; d.ldw = INCOLS; d.dst = (bf16_t*)(ws + WS_WG8 + (size_t)l * 3072 * 1024 + kb * 64); d.ldt = 1024; d.nl0 = nl0; d.mode = 3; d.nper = 48; return d; }
    r -= TR_I_GT;
    if (r < 3 * TR_I_BR) { const int br = r / TR_I_BR, q = r % TR_I_BR, kb = q / 16, nb = q % 16; const float* W = (br == 0 ? p.wbr_a : br == 1 ? p.wbr_b : p.wbr_c) + (size_t)l * 512 * 1024;
        d.src = W + (size_t)kb * 64 * 1024 + nb * 64; d.ldw = 1024; d.dst = (bf16_t*)(ws + WS_WBR) + (size_t)l * 1024 * 1536 + br * 512 + kb * 64; d.ldt = 1536; d.nl0 = nb * 64; d.mode = 0; d.nper = 16; return d; }
    r -= 3 * TR_I_BR;
    { const int kb = r / 16, nb = r % 16;
        d.src = p.w_out + (size_t)l * 1024 * 1024 + (size_t)kb * 64 * 1024 + nb * 64; d.ldw = 1024; d.dst = (bf16_t*)(ws + WS_WOUT) + (size_t)l * 1024 * 1024 + kb * 64; d.ldt = 1024; d.nl0 = nb * 64; d.mode = 0; d.nper = 16; return d; }
}
__device__ __forceinline__ TrDesc tr_decode_expert(const Params& p, int l, int e, int r) {
    unsigned char* ws = p.ws; TrDesc d; const size_t le = (size_t)l * NE + e;
    if (r < 2 * TR_I_G) { const int up = r >= TR_I_G; r -= up * TR_I_G; const int kb = r / 32, nb = r % 32;
        d.src = (up ? p.wu : p.wg) + le * 1024 * 2048 + (size_t)kb * 64 * 2048 + nb * 64; d.ldw = 2048; d.dst = (bf16_t*)(ws + WS_WGU + le * 4096 * 1024 + kb * 64); d.ldt = 1024; d.nl0 = nb * 64; d.mode = 1 + up; d.nper = 32; return d; }
    r -= 2 * TR_I_G;
    { const int kb = r / 16, nb = r % 16;
        d.src = p.wd + le * 2048 * 1024 + (size_t)kb * 64 * 1024 + nb * 64; d.ldw = 1024; d.dst = (bf16_t*)(ws + WS_WDN + le * 1024 * 2048 + kb * 64); d.ldt = 2048; d.nl0 = nb * 64; d.mode = 3; d.nper = 16; return d; }
}
__device__ __forceinline__ TrDesc tr_decode_pro(const Params& p, int it) { return tr_decode_dense(p, it / TR_I_NONEXP, it % TR_I_NONEXP); }
__device__ __forceinline__ TrDesc tr_decode_bg(const Params& p, int q) {
    if (q < TR_BG_L0GU) return tr_decode_expert(p, 0, q / (2 * TR_I_G), q % (2 * TR_I_G));
    if (q < TR_BG_L0) { q -= TR_BG_L0GU; return tr_decode_expert(p, 0, q / TR_I_D, 2 * TR_I_G + q % TR_I_D); }
    if (q < TR_BG_ITEMS) { q -= TR_BG_L0; return tr_decode_expert(p, 1, q / TR_I_EXP, q % TR_I_EXP); }
    q -= TR_BG_ITEMS; return tr_decode_dense(p, 1, q < TR_I_NONEXP ? q : TR_I_NONEXP - 1);
}
__device__ __forceinline__ void convert_item(const Params& p, LAS unsigned char* lds, int e0) {
    const int tid = opaque_tid(), lane = tid & 63, wid = __builtin_amdgcn_readfirstlane(tid >> 6);
    LAS unsigned* scr = (LAS unsigned*)lds + wid * (64 * 66);
    const int q0 = e0 + wid * 32;
    if (q0 < TR_BG_ITEMS + TR_I_NONEXP) {
        TrLane LA = tr_lane(tr_decode_bg(p, q0), lane), LB = LA; tr_adv(LB);
        f32x4 a[8], b[8], a2[8], b2[8]; tr_load_l(LA, a, b);
#pragma unroll 1
        for (int k = 0; k < 32; k += 2) {
            tr_load_l(LB, a2, b2);
            tr_process_l(LA, a, b, scr, lane);
            LA = LB; if (k + 2 < 32) tr_adv(LA);
            tr_load_l(LA, a, b);
            tr_process_l(LB, a2, b2, scr, lane);
            LB = LA; tr_adv(LB);
        }
        asm volatile("" :: "v"(a[0]), "v"(a[1]), "v"(a[2]), "v"(a[3]), "v"(a[4]), "v"(a[5]), "v"(a[6]), "v"(a[7]), "v"(b[0]), "v"(b[1]), "v"(b[2]), "v"(b[3]), "v"(b[4]), "v"(b[5]), "v"(b[6]), "v"(b[7]));
    }
    __syncthreads();
}

__device__ __forceinline__ void prologue(const Params& p, LAS unsigned char* lds) {
    const int tid = opaque_tid(), lane = tid & 63, wid = __builtin_amdgcn_readfirstlane(tid >> 6), G = gridDim.x;
    unsigned char* ws = p.ws;
    { float* cosT = (float*)(ws + WS_ROPE); float* sinT = cosT + LAT * 32;
      for (int idx = blockIdx.x * NTHREADS + tid; idx < LAT * 32; idx += G * NTHREADS) {
          const int t = idx >> 5, i = idx & 31; const float pos = (float)((i < 16) ? (t / GRIDW) : (t % GRIDW));
          const float inv = powf(10000.0f, -(float)(i & 15) / 16.0f); const float ang = pos * inv;
          cosT[idx] = cosf(ang); sinT[idx] = sinf(ang); } }
    if (blockIdx.x < 192) {
        float* MOD = (float*)(ws + WS_MOD); LAS float* sl = (LAS float*)lds; LAS float* red = sl + 9 * 1024;
        for (int o = tid; o < 9 * 1024; o += NTHREADS) { const int m = o >> 10, k = o & 1023; const float cv = (m < 8) ? p.c[m * 1024 + k] : p.c_ctx[k]; sl[o] = cv / (1.0f + expf(-cv)); }
        __syncthreads();
        for (int item = blockIdx.x; item < 192; item += G) {
            const int l = item / 96, cq = lane & 15, rs = lane >> 4;
            f32x4 acc[9];
#pragma unroll
            for (int m = 0; m < 9; ++m) acc[m] = (f32x4){0.f, 0.f, 0.f, 0.f};
            const float* wa = p.w_ada + ((size_t)l * 1024 + wid * 128 + rs) * 6144 + (item % 96) * 64 + 4 * cq;
#pragma unroll 1
            for (int j0 = 0; j0 < 32; j0 += 16) {
                f32x4 wv[16];
#pragma unroll
                for (int jj = 0; jj < 16; ++jj) wv[jj] = __builtin_nontemporal_load((const f32x4*)(wa + (size_t)(4 * (j0 + jj)) * 6144));
#pragma unroll
                for (int jj = 0; jj < 16; ++jj)
#pragma unroll
                    for (int m = 0; m < 9; ++m) acc[m] = acc[m] + wv[jj] * sl[m * 1024 + wid * 128 + rs + 4 * (j0 + jj)];
            }
#pragma unroll
            for (int m = 0; m < 9; ++m) {
#pragma unroll
                for (int e = 0; e < 4; ++e) { float v = acc[m][e]; v += __shfl_xor(v, 16); v += __shfl_xor(v, 32); acc[m][e] = v; }
                if (rs == 0) *(LAS f32x4*)(red + (wid * 9 + m) * 64 + 4 * cq) = acc[m]; }
            __syncthreads();
            for (int o = tid; o < 9 * 64; o += NTHREADS) { const int m = o >> 6, cl = o & 63; float s = 0.f;
#pragma unroll
                for (int w = 0; w < 8; ++w) s += red[(w * 9 + m) * 64 + cl];
                const int cc = (item % 96) * 64 + cl; MOD[((size_t)l * 9 + m) * 6144 + cc] = s + p.b_ada[l * 6144 + cc]; }
            __syncthreads();
        }
    }
    LAS unsigned* scr = (LAS unsigned*)lds + wid * (64 * 66);
    const int NGW = G * NWAVES, NIT = TR_PRO_ITEMS;
    int it = blockIdx.x * NWAVES + wid;
    TrLane L; f32x4 a[8], b[8];
    if (it < NIT) { L = tr_lane(tr_decode_pro(p, it), lane); tr_load_l(L, a, b); }
    while (it < NIT) {
        const int itn = it + NGW; TrLane Ln = L; f32x4 an[8], bn[8];
        if (itn < NIT) { Ln = tr_lane(tr_decode_pro(p, itn), lane); tr_load_l(Ln, an, bn); }
        tr_process_l(L, a, b, scr, lane);
        L = Ln; it = itn;
#pragma unroll
        for (int q = 0; q < 8; ++q) { a[q] = an[q]; b[q] = bn[q]; }
    }
}

__device__ __forceinline__ float reduce16(const float (&acc)[16], int lane) {
    float v8[8], v4[4], v2[2];
    const bool b5 = lane & 32, b4 = lane & 16, b3 = lane & 8, b2 = lane & 4;
#pragma unroll
    for (int i = 0; i < 8; ++i) { const float keep = b5 ? acc[8 + i] : acc[i], send = b5 ? acc[i] : acc[8 + i]; v8[i] = keep + __shfl_xor(send, 32); }
#pragma unroll
    for (int i = 0; i < 4; ++i) { const float keep = b4 ? v8[4 + i] : v8[i], send = b4 ? v8[i] : v8[4 + i]; v4[i] = keep + __shfl_xor(send, 16); }
#pragma unroll
    for (int i = 0; i < 2; ++i) { const float keep = b3 ? v4[2 + i] : v4[i], send = b3 ? v4[i] : v4[2 + i]; v2[i] = keep + __shfl_xor(send, 8); }
    float v1 = (b2 ? v2[1] : v2[0]) + __shfl_xor(b2 ? v2[0] : v2[1], 4);
    v1 += __shfl_xor(v1, 2); v1 += __shfl_xor(v1, 1);
    return v1;
}
template <int MODE>
__device__ __forceinline__ void rowpass(const Params& p, int layer, LAS unsigned char* lds) {
    const int tid = opaque_tid(), lane = tid & 63, wid = __builtin_amdgcn_readfirstlane(tid >> 6), G = gridDim.x;
    unsigned char* ws = p.ws;
    LAS float* wsm = (LAS float*)lds;
    if (MODE != 3) {
        const float* src; size_t stride;
        if (MODE == 1) { src = p.w_router + (size_t)layer * 1024 * NE; stride = NE; }
        else { const int L = (MODE == 0) ? layer : layer + 1; src = p.w_in + (size_t)L * 1024 * INCOLS + 4352; stride = INCOLS; }
        for (int k = tid; k < 1024; k += NTHREADS) { const int slot = ((k >> 8) * 4 + (k & 3)) * 64 + ((k >> 2) & 63);
#pragma unroll
            for (int q = 0; q < 4; ++q) *(LAS f32x4*)(wsm + slot * 20 + 4 * q) = *(const f32x4*)(src + (size_t)k * stride + 4 * q); }
        __syncthreads();
    }
    constexpr int RP = 2;
    const bool latent_only = (MODE == 3) || (MODE == 1 && layer == 1);
    const int NR = latent_only ? NB * LAT : ROWS;
    const int modl = (MODE == 2) ? layer + 1 : layer;
    const float* MOD = (const float*)(ws + WS_MOD);
    bf16_t* XR = (bf16_t*)(ws + WS_XR); bf16_t* H = (bf16_t*)(ws + WS_H);
    const int NW = G * NWAVES;
    const float* nwp = ((MODE == 3) ? p.final_w : (MODE == 1) ? p.norm2_w + (size_t)layer * 1024 : p.norm1_w + (size_t)modl * 1024) + 4 * lane;
    for (int r0 = blockIdx.x * NWAVES + wid; r0 < NR; r0 += RP * NW) {
        int bb[RP], tt[RP], bms[RP]; size_t rows[RP]; bool valid[RP];
        f32x4 xv[RP][4];
#pragma unroll
        for (int r = 0; r < RP; ++r) {
            const int ri_ = r0 + r * NW; valid[r] = ri_ < NR; const int ri = valid[r] ? ri_ : r0;
            if (latent_only) { bb[r] = ri >> 11; tt[r] = CTXL + (ri & 2047); } else { bb[r] = ri / TOK; tt[r] = ri % TOK; }
            rows[r] = (size_t)bb[r] * TOK + tt[r]; bms[r] = (tt[r] < CTXL) ? 8 : bb[r];
            if (MODE == 0) {
                const float* src = (tt[r] < CTXL) ? p.ctx + ((size_t)bb[r] * CTXL + tt[r]) * 1024 : p.x + ((size_t)bb[r] * LAT + (tt[r] - CTXL)) * 1024;
#pragma unroll
                for (int j = 0; j < 4; ++j) xv[r][j] = *(const f32x4*)(src + 4 * lane + 256 * j);
            } else {
                const bf16_t* src = XR + rows[r] * 1024 + 4 * lane;
#pragma unroll
                for (int j = 0; j < 4; ++j) { const u32x2 w = *(const u32x2*)(src + 256 * j); xv[r][j] = (f32x4){bflo(w.x), bfhi(w.x), bflo(w.y), bfhi(w.y)}; }
            }
        }
        f32x4 nwv[4], shv[RP][4], scv[RP][4], g2v[RP][4];
#pragma unroll
        for (int j = 0; j < 4; ++j) nwv[j] = *(const f32x4*)(nwp + 256 * j);
#pragma unroll
        for (int r = 0; r < RP; ++r) {
            const float* md = MOD + ((size_t)modl * 9 + bms[r]) * 6144 + ((MODE == 1) ? 3072 : 0) + 4 * lane;
            const float* g2 = MOD + ((size_t)layer * 9 + bms[r]) * 6144 + 5120 + 4 * lane;
#pragma unroll
            for (int j = 0; j < 4; ++j) {
                if (MODE != 3) { shv[r][j] = *(const f32x4*)(md + 256 * j); scv[r][j] = *(const f32x4*)(md + 1024 + 256 * j); }
                if (MODE == 2 || MODE == 3) g2v[r][j] = *(const f32x4*)(g2 + 256 * j); }
        }
        if (MODE == 2 || MODE == 3) {
            const bf16_t* YE = (const bf16_t*)(ws + WS_YE);
            int slv[RP]; unsigned msk[RP]; f32x4 sum[RP][4];
#pragma unroll
            for (int r = 0; r < RP; ++r) { slv[r] = ((const int*)(ws + WS_SLOT))[rows[r] * NE + (lane & 15)]; msk[r] = (unsigned)__ballot(slv[r] >= 0) & 0xffffu;
#pragma unroll
                for (int j = 0; j < 4; ++j) sum[r][j] = (f32x4){0.f, 0.f, 0.f, 0.f}; }
            while (msk[0] | msk[RP - 1]) {
                u32x2 w[RP][2][4]; float on[RP][2];
#pragma unroll
                for (int r = 0; r < RP; ++r)
#pragma unroll
                    for (int q = 0; q < 2; ++q) {
                        const bool has = msk[r] != 0u; const int e = has ? __builtin_ctz(msk[r]) : 0; msk[r] &= msk[r] - 1u; on[r][q] = has ? 1.f : 0.f;
                        int s = __builtin_amdgcn_readlane(slv[r], e); s = has ? s : 0;
                        const size_t yrow = (tt[r] < CTXL) ? (size_t)(e * 9 + 8) * 256 + bb[r] * 32 + s : (size_t)(e * 9 + bb[r]) * 256 + s; const bf16_t* yp = YE + yrow * 1024 + 4 * lane;
#pragma unroll
                        for (int j = 0; j < 4; ++j) w[r][q][j] = *(const u32x2*)(yp + 256 * j);
                    }
#pragma unroll
                for (int r = 0; r < RP; ++r)
#pragma unroll
                    for (int q = 0; q < 2; ++q)
#pragma unroll
                        for (int j = 0; j < 4; ++j) sum[r][j] = sum[r][j] + (f32x4){bflo(w[r][q][j].x), bfhi(w[r][q][j].x), bflo(w[r][q][j].y), bfhi(w[r][q][j].y)} * on[r][q];
            }
#pragma unroll
            for (int r = 0; r < RP; ++r) {
#pragma unroll
                for (int j = 0; j < 4; ++j) xv[r][j] = xv[r][j] + g2v[r][j] * sum[r][j];
                if (MODE == 2 && valid[r]) {
#pragma unroll
                    for (int j = 0; j < 4; ++j) *(u32x2*)(XR + rows[r] * 1024 + 4 * lane + 256 * j) = (u32x2){cvtpk(xv[r][j][0], xv[r][j][1]), cvtpk(xv[r][j][2], xv[r][j][3])}; }
            }
        }
        float rinv[RP];
        { float ss[RP];
#pragma unroll
          for (int r = 0; r < RP; ++r) { ss[r] = 0.f;
#pragma unroll
              for (int j = 0; j < 4; ++j) ss[r] += (xv[r][j][0] * xv[r][j][0] + xv[r][j][1] * xv[r][j][1]) + (xv[r][j][2] * xv[r][j][2] + xv[r][j][3] * xv[r][j][3]); }
#pragma unroll
          for (int o = 1; o < 64; o <<= 1) {
#pragma unroll
              for (int r = 0; r < RP; ++r) ss[r] += __shfl_xor(ss[r], o); }
#pragma unroll
          for (int r = 0; r < RP; ++r) rinv[r] = rsqrtf(ss[r] * (1.0f / 1024.0f) + EPS); }
        if (MODE == 3) {
#pragma unroll
            for (int r = 0; r < RP; ++r) if (valid[r]) {
                float* o = p.out + ((size_t)bb[r] * LAT + (tt[r] - CTXL)) * 1024 + 4 * lane;
#pragma unroll
                for (int j = 0; j < 4; ++j) *(f32x4*)(o + 256 * j) = xv[r][j] * rinv[r] * nwv[j]; }
            continue;
        }
        f32x4 hv[RP][4];
#pragma unroll
        for (int r = 0; r < RP; ++r) {
#pragma unroll
            for (int j = 0; j < 4; ++j) { const f32x4 sh = shv[r][j], sc = scv[r][j];
                hv[r][j] = (xv[r][j] * rinv[r] * nwv[j]) * (sc + 1.0f) + sh;
                if (valid[r]) { if (MODE == 1) *(unsigned*)((unsigned char*)H + rows[r] * 1024 + 4 * lane + 256 * j) = cvt4_fp8(hv[r][j][0], hv[r][j][1], hv[r][j][2], hv[r][j][3]);
                                else { *(u32x2*)(H + rows[r] * 1024 + 4 * lane + 256 * j) = (u32x2){cvtpk(hv[r][j][0], hv[r][j][1]), cvtpk(hv[r][j][2], hv[r][j][3])};
                                       *(unsigned*)(ws + WS_H8IN + rows[r] * 1024 + 4 * lane + 256 * j) = cvt4_fp8(hv[r][j][0], hv[r][j][1], hv[r][j][2], hv[r][j][3]); } } }
        }
        float acc[RP][16];
#pragma unroll
        for (int r = 0; r < RP; ++r)
#pragma unroll
            for (int e = 0; e < 16; ++e) acc[r][e] = 0.f;
#pragma unroll
        for (int j = 0; j < 4; ++j)
#pragma unroll
            for (int i = 0; i < 4; ++i) { const LAS float* wp = wsm + ((4 * j + i) * 64 + lane) * 20;
#pragma unroll
                for (int q = 0; q < 4; ++q) { const f32x4 w = *(const LAS f32x4*)(wp + 4 * q);
#pragma unroll
                    for (int r = 0; r < RP; ++r) { const float h = hv[r][j][i]; acc[r][4 * q + 0] += h * w[0]; acc[r][4 * q + 1] += h * w[1]; acc[r][4 * q + 2] += h * w[2]; acc[r][4 * q + 3] += h * w[3]; } }
                __builtin_amdgcn_sched_barrier(0); }
        float red[RP];
#pragma unroll
        for (int r = 0; r < RP; ++r) red[r] = reduce16(acc[r], lane);
        int eidx = ((lane >> 5) & 1) * 8 + ((lane >> 4) & 1) * 4 + ((lane >> 3) & 1) * 2 + ((lane >> 2) & 1);
        asm volatile("" : "+v"(eidx));
#pragma unroll
        for (int r = 0; r < RP; ++r) {
            if (MODE == 1) {
                float mx = red[r];
#pragma unroll
                for (int o = 4; o < 64; o <<= 1) mx = fmaxf(mx, __shfl_xor(mx, o));
                const float ex = expf(red[r] - mx); float sum = ex;
#pragma unroll
                for (int o = 4; o < 64; o <<= 1) sum += __shfl_xor(sum, o);
                if (valid[r] && (lane & 3) == 0) ((float*)(ws + WS_AFF))[((size_t)bb[r] * NE + eidx) * TOK + tt[r]] = ex / sum;
            } else {
                if (valid[r] && (lane & 3) == 0) ((float*)(ws + WS_GATES))[rows[r] * 16 + eidx] = red[r];
            }
        }
    }
}

namespace ml {
constexpr int QP = 136, VP = 136;
constexpr int O_Q = 0, O_K = 34816, O_V = 69632, O_C = 104448, O_F = 139264;
constexpr int FSET = 656, F_AG = 0, F_BQ = 128, F_WI = 256, F_EM = 384, F_WW = 512, F_SC = 640, F_NV = 2 * FSET, F_NP = 2 * FSET + 128;
__device__ __forceinline__ s16x4 trr(const LAS bf16_t* p) { return __builtin_bit_cast(s16x4, __builtin_amdgcn_ds_read_tr16_b64_v4i16((LAS s16x4*)p)); }
__device__ __forceinline__ bf16x8 cat8(s16x4 a, s16x4 b) { return (bf16x8){a[0], a[1], a[2], a[3], b[0], b[1], b[2], b[3]}; }
__device__ __forceinline__ float fast_exp(float x) { return __builtin_amdgcn_exp2f(x * 1.4426950408889634f); }

#define ML_CHUNK(ci, L_, c_, rowb_) const bool isctx_ = (ci) < 2; const int L_ = isctx_ ? CTXL : LAT, c_ = isctx_ ? (ci) : (ci) - 2; const size_t rowb_ = (size_t)b * TOK + (isctx_ ? 0 : CTXL)

__device__ __forceinline__ void mlstm_item(const Params& p, int layer, int item, LAS unsigned char* lds) {
    const int tid = opaque_tid(), lane = tid & 63, wid = __builtin_amdgcn_readfirstlane(tid >> 6);
    const int b = item >> 3, head = (item >> 1) & 3, dir = item & 1;
    LAS bf16_t* Qs = (LAS bf16_t*)(lds + O_Q); LAS bf16_t* Ks = (LAS bf16_t*)(lds + O_K);
    LAS bf16_t* Vs = (LAS bf16_t*)(lds + O_V); LAS bf16_t* Cs = (LAS bf16_t*)(lds + O_C); LAS float* F = (LAS float*)(lds + O_F);
    const bf16_t* P = (const bf16_t*)(p.ws + WS_P); const float* GATES = (const float*)(p.ws + WS_GATES); bf16_t* HF = (bf16_t*)(p.ws + WS_HF);
    for (int i = tid; i < 128 * QP / 2; i += NTHREADS) ((LAS unsigned*)Cs)[i] = 0u;
    if (tid < 128) F[F_NV + tid] = 0.f;
    f32x16 Cacc[2];
#pragma unroll
    for (int r = 0; r < 16; ++r) { Cacc[0][r] = 0.f; Cacc[1][r] = 0.f; }
    const float gbi = p.gate_b[layer * 16 + dir * 8 + head], gbf = p.gate_b[layer * 16 + dir * 8 + 4 + head];
    float m_state = 0.f, gi0 = 0.f, gi1 = 0.f, gf0 = 0.f, gf1 = 0.f;
#define ML_LOAD_GATES(ci) do { ML_CHUNK(ci, Lg, cg_, rbg); \
        int g0_ = cg_ * 128 + 2 * lane; int t0_ = dir ? (Lg - 1 - g0_) : g0_, t1_ = dir ? (Lg - 2 - g0_) : (g0_ + 1); asm volatile("" : "+v"(t0_), "+v"(t1_)); \
        const float* ga_ = GATES + (rbg + t0_) * 16; const float* gb_ = GATES + (rbg + t1_) * 16; \
        gi0 = ga_[dir * 8 + head]; gf0 = ga_[dir * 8 + 4 + head]; gi1 = gb_[dir * 8 + head]; gf1 = gb_[dir * 8 + 4 + head]; } while (0)
#define ML_SCAN(st) do { LAS float* Fs = F + (st) * FSET; \
        const float fp0 = gf0 + gbf, fp1 = gf1 + gbf; \
        const float l0 = fminf(fp0, 0.f) - log1pf(expf(-fabsf(fp0))), l1 = fminf(fp1, 0.f) - log1pf(expf(-fabsf(fp1))); \
        const float s_ = l0 + l1; float incl = s_; \
        _Pragma("unroll") for (int o = 1; o < 64; o <<= 1) { const float tt = __shfl_up(incl, o); if (lane >= o) incl += tt; } \
        const float b0 = (incl - s_) + l0, b1 = incl; \
        const float a0 = (gi0 + gbi) - b0, a1 = (gi1 + gbi) - b1; \
        float inclm = fmaxf(a0, a1); \
        _Pragma("unroll") for (int o = 1; o < 64; o <<= 1) { const float tt = __shfl_up(inclm, o); if (lane >= o) inclm = fmaxf(inclm, tt); } \
        float exclm = __shfl_up(inclm, 1); if (lane == 0) exclm = -3.0e38f; \
        const float am0 = fmaxf(exclm, a0), am1 = inclm; \
        const float mt0 = b0 + fmaxf(m_state, am0), mt1 = b1 + fmaxf(m_state, am1); \
        const float blast = __shfl(b1, 63), amax = __shfl(inclm, 63); const float mnew_ = blast + fmaxf(m_state, amax); \
        *(LAS f32x2*)(Fs + F_AG + 2 * lane) = (f32x2){a0, a1}; *(LAS f32x2*)(Fs + F_BQ + 2 * lane) = (f32x2){b0 - mt0, b1 - mt1}; \
        *(LAS f32x2*)(Fs + F_WI + 2 * lane) = (f32x2){fast_exp(b0 + m_state - mt0), fast_exp(b1 + m_state - mt1)}; \
        *(LAS f32x2*)(Fs + F_EM + 2 * lane) = (f32x2){fast_exp(-mt0), fast_exp(-mt1)}; \
        *(LAS f32x2*)(Fs + F_WW + 2 * lane) = (f32x2){fast_exp(blast + a0 - mnew_), fast_exp(blast + a1 - mnew_)}; \
        if (lane == 0) { Fs[F_SC] = mnew_; Fs[F_SC + 1] = fast_exp(blast + m_state - mnew_); } \
        m_state = mnew_; } while (0)
#define ML_LOADS(ci) u32x4 xq[10]; unsigned hmask = 0u; do { ML_CHUNK(ci, Ll, cl, rbl); int g0_ = cl * 128 + 8 * rg - 1; asm volatile("" : "+v"(g0_)); \
        _Pragma("unroll") for (int i = 0; i < 10; ++i) { const int g_ = g0_ + i; const bool ok_ = g_ >= 0 && g_ < Ll; const int gc_ = ok_ ? g_ : g0_ + 1; \
            const int tk_ = dir ? (Ll - 1 - gc_) : gc_; hmask |= ok_ ? (1u << i) : 0u; xq[i] = *(const u32x4*)(P + (rbl + tk_) * NPROJ + qkcol); } } while (0)
    if (wid == 0) { ML_LOAD_GATES(0); }
    __syncthreads();
    for (int ci = 0; ci < 18; ++ci) {
        ML_CHUNK(ci, L, c, rowb);
        LAS float* Fc = F + (ci & 1) * FSET;
        int tid_o = tid; asm volatile("" : "+v"(tid_o));
        const int lane_o = tid_o & 63, r32 = lane_o & 31, hi = lane_o >> 5; const int lane = lane_o;
        const int cg = tid_o & 31, rg = tid_o >> 5; const bool isk = cg >= 16; const int chq = 8 * (cg & 15);
        const int qkcol = (isk ? PC_CK : PC_CQ) + head * 128 + chq; const float* cwp = p.conv_w + (size_t)layer * 3 * 1024 + (isk ? 512 : 0) + head * 128 + chq;
        const int tauv = tid_o >> 2, dgv = tid_o & 3;
#define ML_TOK(tau) (dir ? (L - 1 - (c * 128 + (tau))) : (c * 128 + (tau)))
        ML_LOADS(ci);
        if (wid == 0) { ML_SCAN(ci & 1); if (ci + 1 < 18) { ML_LOAD_GATES(ci + 1); } }
        {
            u32x4 xv[4];
            { int gv_ = c * 128 + tauv; asm volatile("" : "+v"(gv_)); const int tkv_ = dir ? (L - 1 - gv_) : gv_; const bf16_t* vs_ = P + (rowb + tkv_) * NPROJ + PC_CV + head * 128 + dgv * 32;
#pragma unroll
              for (int q = 0; q < 4; ++q) xv[q] = *(const u32x4*)(vs_ + 8 * q); }
#define ML_UNPACK(dst, i) do { const bool ok_ = (hmask >> (i)) & 1u; const u32x4 w_ = xq[i]; \
                dst[0] = ok_ ? bflo(w_.x) : 0.f; dst[1] = ok_ ? bfhi(w_.x) : 0.f; dst[2] = ok_ ? bflo(w_.y) : 0.f; dst[3] = ok_ ? bfhi(w_.y) : 0.f; \
                dst[4] = ok_ ? bflo(w_.z) : 0.f; dst[5] = ok_ ? bfhi(w_.z) : 0.f; dst[6] = ok_ ? bflo(w_.w) : 0.f; dst[7] = ok_ ? bfhi(w_.w) : 0.f; } while (0)
            float wlo[8], wmd[8], whi[8];
            { int wo_ = dir ? 2048 : 0; asm volatile("" : "+v"(wo_));
              const f32x4 a0_ = *(const f32x4*)(cwp + wo_), a1_ = *(const f32x4*)(cwp + wo_ + 4), m0_ = *(const f32x4*)(cwp + 1024), m1_ = *(const f32x4*)(cwp + 1028), c0_ = *(const f32x4*)(cwp + 2048 - wo_), c1_ = *(const f32x4*)(cwp + 2052 - wo_);
#pragma unroll
              for (int e = 0; e < 4; ++e) { wlo[e] = a0_[e]; wlo[4 + e] = a1_[e]; wmd[e] = m0_[e]; wmd[4 + e] = m1_[e]; whi[e] = c0_[e]; whi[4 + e] = c1_[e]; } }
            float xa[8], xb[8], xc[8];
            ML_UNPACK(xa, 0); ML_UNPACK(xb, 1);
            LAS bf16_t* dstb = (isk ? Ks : Qs) + (8 * rg) * QP + chq; const float osc = isk ? 0.08838834764831845f : 1.0f;
#pragma unroll
            for (int r = 0; r < 8; ++r) { float o[8];
                ML_UNPACK(xc, r + 2);
#pragma unroll
                for (int e = 0; e < 8; ++e) o[e] = fast_silu(wlo[e] * xa[e] + wmd[e] * xb[e] + whi[e] * xc[e]) * osc;
                *(LAS u32x4*)(dstb + r * QP) = (u32x4){cvtpk(o[0], o[1]), cvtpk(o[2], o[3]), cvtpk(o[4], o[5]), cvtpk(o[6], o[7])};
#pragma unroll
                for (int e = 0; e < 8; ++e) { xa[e] = xb[e]; xb[e] = xc[e]; } }
#undef ML_UNPACK
#pragma unroll
            for (int q = 0; q < 4; ++q) *(LAS u32x4*)(Vs + tauv * VP + dgv * 32 + 8 * q) = xv[q];
        }
        __syncthreads();
        const float decay = Fc[F_SC + 1];
        const int tb = wid >> 1, vpr = wid & 1; const int t_abs = 32 * tb + r32;
        int qoff = t_abs * QP + 8 * hi;
#define ML_QF(ks) (*(const LAS bf16x8*)(Qs + qoff + 16 * (ks)))
        f32x16 acc[2];
#pragma unroll
        for (int r = 0; r < 16; ++r) { acc[0][r] = 0.f; acc[1][r] = 0.f; }
#pragma unroll
        for (int ks = 0; ks < 8; ++ks)
#pragma unroll
            for (int u = 0; u < 2; ++u) { const bf16x8 cf = *(const LAS bf16x8*)(Cs + (32 * (2 * vpr + u) + r32) * QP + 16 * ks + 8 * hi); acc[u] = __builtin_amdgcn_mfma_f32_32x32x16_bf16(cf, ML_QF(ks), acc[u], 0, 0, 0); }
        const float wi_t = Fc[F_WI + t_abs], bq_t = Fc[F_BQ + t_abs];
#pragma unroll
        for (int r = 0; r < 16; ++r) { acc[0][r] *= wi_t; acc[1][r] *= wi_t; }
        float dsum = 0.f;
        const int trl = ((lane_o & 15) >> 2), tcl = 16 * ((lane_o >> 4) & 1) + 4 * (lane_o & 3);
        for (int sb = 0; sb <= tb; ++sb) {
            f32x16 st;
#pragma unroll
            for (int r = 0; r < 16; ++r) st[r] = 0.f;
            asm volatile("" : "+v"(qoff));
#pragma unroll
            for (int ks = 0; ks < 8; ++ks) { const bf16x8 kf = *(const LAS bf16x8*)(Ks + (32 * sb + r32) * QP + 16 * ks + 8 * hi); st = __builtin_amdgcn_mfma_f32_32x32x16_bf16(kf, ML_QF(ks), st, 0, 0, 0); }
            float pv[16];
#pragma unroll
            for (int r = 0; r < 16; ++r) { const int s_abs = 32 * sb + (r & 3) + 8 * (r >> 2) + 4 * hi;
                const float dd = __builtin_amdgcn_exp2f((bq_t + Fc[F_AG + s_abs]) * 1.4426950408889634f);
                const float val = (s_abs <= t_abs) ? st[r] * dd : 0.f; dsum += val; pv[r] = val; }
#pragma unroll
            for (int ksp = 0; ksp < 2; ++ksp) {
                const u32x4 pw = {cvtpk(pv[8 * ksp], pv[8 * ksp + 1]), cvtpk(pv[8 * ksp + 2], pv[8 * ksp + 3]), cvtpk(pv[8 * ksp + 4], pv[8 * ksp + 5]), cvtpk(pv[8 * ksp + 6], pv[8 * ksp + 7])};
#pragma unroll
                for (int u = 0; u < 2; ++u) {
                    const LAS bf16_t* va = Vs + (32 * sb + 16 * ksp + 4 * hi + trl) * VP + 32 * (2 * vpr + u) + tcl;
                    const bf16x8 vf = cat8(trr(va), trr(va + 8 * VP));
                    acc[u] = __builtin_amdgcn_mfma_f32_32x32x16_bf16(vf, __builtin_bit_cast(bf16x8, pw), acc[u], 0, 0, 0);
                }
            }
        }
        dsum += __shfl_xor(dsum, 32);
        float dq = 0.f;
#pragma unroll
        for (int c8 = 0; c8 < 8; ++c8) { const u32x4 qv = *(const LAS u32x4*)(Qs + t_abs * QP + 64 * hi + 8 * c8); const LAS float* nv = F + F_NV + 64 * hi + 8 * c8;
            dq += bflo(qv.x) * nv[0] + bfhi(qv.x) * nv[1] + bflo(qv.y) * nv[2] + bfhi(qv.y) * nv[3] + bflo(qv.z) * nv[4] + bfhi(qv.z) * nv[5] + bflo(qv.w) * nv[6] + bfhi(qv.w) * nv[7]; }
        dq += __shfl_xor(dq, 32);
        { const float den = dsum + wi_t * dq; const float inv = 1.0f / fmaxf(fabsf(den), Fc[F_EM + t_abs]);
          const int tok = ML_TOK(t_abs);
#pragma unroll
          for (int u = 0; u < 2; ++u) {
              bf16_t* o = HF + ((size_t)dir * ROWS + rowb + tok) * 512 + head * 128 + 32 * (2 * vpr + u) + 4 * hi;
#pragma unroll
              for (int g = 0; g < 4; ++g) *(u32x2*)(o + 8 * g) = (u32x2){cvtpk(acc[u][4 * g] * inv, acc[u][4 * g + 1] * inv), cvtpk(acc[u][4 * g + 2] * inv, acc[u][4 * g + 3] * inv)}; } }
        { const int vp2 = wid & 1, db = wid >> 1;
#pragma unroll
          for (int r = 0; r < 16; ++r) { Cacc[0][r] *= decay; Cacc[1][r] *= decay; }
#pragma unroll
          for (int ks = 0; ks < 8; ++ks) { const int R0 = 16 * ks + 8 * hi + trl;
              const LAS bf16_t* ka = Ks + R0 * QP + 32 * db + tcl;
              const s16x4 k0 = trr(ka), k1 = trr(ka + 4 * QP);
              const f32x4 w0 = *(const LAS f32x4*)(Fc + F_WW + 16 * ks + 8 * hi), w1 = *(const LAS f32x4*)(Fc + F_WW + 16 * ks + 8 * hi + 4);
              const u32x4 kw = {cvtpk(bf2f((unsigned short)k0[0]) * w0[0], bf2f((unsigned short)k0[1]) * w0[1]), cvtpk(bf2f((unsigned short)k0[2]) * w0[2], bf2f((unsigned short)k0[3]) * w0[3]),
                                cvtpk(bf2f((unsigned short)k1[0]) * w1[0], bf2f((unsigned short)k1[1]) * w1[1]), cvtpk(bf2f((unsigned short)k1[2]) * w1[2], bf2f((unsigned short)k1[3]) * w1[3])};
#pragma unroll
              for (int u = 0; u < 2; ++u) { const LAS bf16_t* va = Vs + R0 * VP + 32 * (2 * vp2 + u) + tcl;
                  const bf16x8 af = cat8(trr(va), trr(va + 4 * VP));
                  Cacc[u] = __builtin_amdgcn_mfma_f32_32x32x16_bf16(af, __builtin_bit_cast(bf16x8, kw), Cacc[u], 0, 0, 0); } }
          { float sp = 0.f; const int dd = tid_o & 127, part = tid_o >> 7;
#pragma unroll 8
            for (int s_ = 0; s_ < 32; ++s_) sp += Fc[F_WW + part * 32 + s_] * bf2f(Ks[(part * 32 + s_) * QP + dd]);
            F[F_NP + tid_o] = sp; }
          __syncthreads();
          float nnew = 0.f;
          if (tid_o < 128) nnew = decay * F[F_NV + tid_o] + ((F[F_NP + tid_o] + F[F_NP + 128 + tid_o]) + (F[F_NP + 256 + tid_o] + F[F_NP + 384 + tid_o]));
#pragma unroll
          for (int u = 0; u < 2; ++u)
#pragma unroll
              for (int r = 0; r < 16; ++r) { const int v = 32 * (2 * vp2 + u) + (r & 3) + 8 * (r >> 2) + 4 * hi; Cs[v * QP + 32 * db + r32] = (bf16_t)(cvtpk(Cacc[u][r], 0.f) & 0xffffu); }
          if (tid_o < 128) F[F_NV + tid_o] = nnew;
        }
#undef ML_TOK
#undef ML_QF
    }
    __syncthreads();
#undef ML_LOADS
#undef ML_SCAN
#undef ML_LOAD_GATES
}
#undef ML_CHUNK
}

__device__ __forceinline__ void postmix(const Params& p, int layer) {
    const int tid = opaque_tid(), lane = tid & 63, wid = __builtin_amdgcn_readfirstlane(tid >> 6), G = gridDim.x;
    unsigned char* ws = p.ws;
    const float* lv = p.dlam + (size_t)layer * 256;
    const float d01 = wave_sum(lv[lane] * lv[64 + lane]), d23 = wave_sum(lv[128 + lane] * lv[192 + lane]);
    const float lam_init = 0.8f - 0.6f * expf(-0.3f * (float)layer); const float lam = expf(d01) - expf(d23) + lam_init;
    const bf16_t* OAP = (const bf16_t*)(ws + WS_OAP); const bf16_t* HF = (const bf16_t*)(ws + WS_HF); const bf16_t* P = (const bf16_t*)(ws + WS_P); bf16_t* OABC = (bf16_t*)(ws + WS_OABC);
    const f32x2 sw = *(const f32x2*)(p.subln_w + (size_t)layer * 128 + 2 * lane);
    f32x2 mw[4];
#pragma unroll
    for (int h = 0; h < 4; ++h) mw[h] = *(const f32x2*)(p.mnorm_w + (size_t)layer * 512 + h * 128 + 2 * lane);
    const bool latent_only = layer == 1; const int NR = latent_only ? NB * LAT : ROWS;
    constexpr int RP = 2; const int NW = G * NWAVES;
    for (int r0 = blockIdx.x * NWAVES + wid; r0 < NR; r0 += RP * NW) {
        size_t rows[RP]; bool valid[RP];
        unsigned w0[RP][4], w1[RP][4], so[RP][4], h0[RP][4], h1[RP][4];
#pragma unroll
        for (int r = 0; r < RP; ++r) {
            const int ri_ = r0 + r * NW; valid[r] = ri_ < NR; const int ri = valid[r] ? ri_ : r0;
            rows[r] = latent_only ? (size_t)(ri >> 11) * TOK + CTXL + (ri & 2047) : (size_t)ri;
#pragma unroll
            for (int h = 0; h < 4; ++h) { const int cidx = h * 128 + 2 * lane;
                w0[r][h] = *(const unsigned*)(OAP + rows[r] * 1024 + h * 256 + 2 * lane); w1[r][h] = *(const unsigned*)(OAP + rows[r] * 1024 + h * 256 + 128 + 2 * lane);
                h0[r][h] = *(const unsigned*)(HF + rows[r] * 512 + cidx); h1[r][h] = *(const unsigned*)(HF + ((size_t)ROWS + rows[r]) * 512 + cidx);
                so[r][h] = *(const unsigned*)(P + rows[r] * NPROJ + PC_CO + cidx); }
        }
        float da[RP][4], db[RP][4], ha[RP][4], hb[RP][4], sa[RP][4], sc[RP][4];
#pragma unroll
        for (int r = 0; r < RP; ++r)
#pragma unroll
            for (int h = 0; h < 4; ++h) {
                da[r][h] = bflo(w0[r][h]) - lam * bflo(w1[r][h]); db[r][h] = bfhi(w0[r][h]) - lam * bfhi(w1[r][h]); sa[r][h] = da[r][h] * da[r][h] + db[r][h] * db[r][h];
                ha[r][h] = bflo(h0[r][h]) + bflo(h1[r][h]); hb[r][h] = bfhi(h0[r][h]) + bfhi(h1[r][h]); sc[r][h] = ha[r][h] * ha[r][h] + hb[r][h] * hb[r][h]; }
#pragma unroll
        for (int o = 1; o < 64; o <<= 1)
#pragma unroll
            for (int r = 0; r < RP; ++r)
#pragma unroll
                for (int h = 0; h < 4; ++h) { sa[r][h] += __shfl_xor(sa[r][h], o); sc[r][h] += __shfl_xor(sc[r][h], o); }
#pragma unroll
        for (int r = 0; r < RP; ++r) if (valid[r]) {
#pragma unroll
            for (int h = 0; h < 4; ++h) {
                const float ra = rsqrtf(sa[r][h] * (1.0f / 128.0f) + EPS) * (1.0f - lam_init), rc = rsqrtf(sc[r][h] * (1.0f / 128.0f) + EPS);
                *(unsigned*)(OABC + rows[r] * 1536 + h * 128 + 2 * lane) = cvtpk(da[r][h] * ra * sw[0], db[r][h] * ra * sw[1]);
                *(unsigned*)(OABC + rows[r] * 1536 + 1024 + h * 128 + 2 * lane) = cvtpk(ha[r][h] * rc * mw[h][0] * bflo(so[r][h]), hb[r][h] * rc * mw[h][1] * bfhi(so[r][h]));
            }
        }
    }
}

__device__ __forceinline__ void topk_item(const Params& p, int item, LAS unsigned char* lds) {
    const int tid = opaque_tid(), lane = tid & 63, wid = __builtin_amdgcn_readfirstlane(tid >> 6);
    unsigned char* ws = p.ws;
    const bool isctx = item >= 128; const int be = item & 127, b = be >> 4, e = be & 15;
    const int N = isctx ? CTXL : LAT, cap = isctx ? 32 : 256;
    const float* a = (const float*)(ws + WS_AFF) + ((size_t)b * NE + e) * TOK + (isctx ? 0 : CTXL);
    const size_t rowbase = (size_t)b * TOK + (isctx ? 0 : CTXL);
    const size_t xrow0 = isctx ? (size_t)(e * 9 + 8) * 256 + b * 32 : (size_t)(e * 9 + b) * 256;
    LAS unsigned* cntw = (LAS unsigned*)lds;
    LAS unsigned* segs = (LAS unsigned*)lds + 64;
    unsigned key[4]; float val[4];
#pragma unroll
    for (int it = 0; it < 4; ++it) { const int n = it * NTHREADS + tid; val[it] = (n < N) ? a[n] : 0.f; key[it] = (n < N) ? __float_as_uint(val[it]) : 0u; }
    unsigned T = 0u;
    for (int pos = 30; pos >= 0; pos -= 2) {
        unsigned cnt[3];
#pragma unroll
        for (int d = 0; d < 3; ++d) { const unsigned trial = T | ((unsigned)(d + 1) << pos); cnt[d] = 0u;
#pragma unroll
            for (int it = 0; it < 4; ++it) cnt[d] += (unsigned)__builtin_popcountll(__ballot(key[it] >= trial)); }
        LAS unsigned* cw = cntw + ((pos >> 1) & 1) * 32;
        if (lane == 0) { cw[wid * 4] = cnt[0]; cw[wid * 4 + 1] = cnt[1]; cw[wid * 4 + 2] = cnt[2]; }
        __syncthreads();
        unsigned tot[3] = {0u, 0u, 0u};
#pragma unroll
        for (int w = 0; w < 8; ++w) { tot[0] += cw[w * 4]; tot[1] += cw[w * 4 + 1]; tot[2] += cw[w * 4 + 2]; }
        const unsigned dsel = (tot[2] >= (unsigned)cap) ? 3u : (tot[1] >= (unsigned)cap) ? 2u : (tot[0] >= (unsigned)cap) ? 1u : 0u;
        T |= dsel << pos;
    }
    const unsigned long long ltmask = (1ull << lane) - 1ull;
    unsigned pg[4], pe[4];
#pragma unroll
    for (int it = 0; it < 4; ++it) { const unsigned long long bg = __ballot(key[it] > T), bq = __ballot(key[it] == T);
        pg[it] = (unsigned)__builtin_popcountll(bg & ltmask); pe[it] = (unsigned)__builtin_popcountll(bq & ltmask);
        if (lane == 0) { segs[it * 8 + wid] = (unsigned)__builtin_popcountll(bg); segs[32 + it * 8 + wid] = (unsigned)__builtin_popcountll(bq); } }
    __syncthreads();
    unsigned totg = 0u;
    for (int s = 0; s < 32; ++s) totg += segs[s];
    const unsigned need = (unsigned)cap - totg;
    int* SLOT = (int*)(ws + WS_SLOT); float* GSEL = (float*)(ws + WS_GSEL); int* XIDX = (int*)(ws + WS_XIDX);
#pragma unroll
    for (int it = 0; it < 4; ++it) { const int n = it * NTHREADS + tid; const int seg = it * 8 + wid;
        unsigned prg = 0u, pre = 0u;
        for (int s = 0; s < seg; ++s) { prg += segs[s]; pre += segs[32 + s]; }
        if (n < N) { const unsigned rank_eq = pre + pe[it]; const bool sel = (key[it] > T) || (key[it] == T && rank_eq < need);
            int slot = -1;
            if (sel) { const unsigned eqb = rank_eq < need ? rank_eq : need; slot = (int)(prg + pg[it] + eqb); XIDX[xrow0 + slot] = (int)rowbase + n; GSEL[xrow0 + slot] = val[it]; }
            SLOT[(rowbase + n) * NE + e] = slot; } }
    __syncthreads();
}
#define XB_TMO      128
#define XB_XCNT(j)  (256  + 64 * (j))
#define XB_XSUB(j)  (1280 + 64 * (j))
#define XB_XGEN(j)  (2304 + 64 * (j))
#define XB_TOP      3328
#define XB_TOPGEN   3392
#define XCD_BAR_WORDS 3456
#define XB_SPIN_CAP (1u << 18)

__device__ __forceinline__ unsigned xb_ld(unsigned* p)              { return __hip_atomic_load(p, __ATOMIC_RELAXED, __HIP_MEMORY_SCOPE_AGENT); }
__device__ __forceinline__ unsigned xb_add(unsigned* p, unsigned v) { return __hip_atomic_fetch_add(p, v, __ATOMIC_RELAXED, __HIP_MEMORY_SCOPE_AGENT); }
__device__ __forceinline__ unsigned xb_xcc_id() { return (unsigned)__builtin_amdgcn_s_getreg((3 << 11) | 20) & 0xFu; }
#define XB_SPIN(cond, bar) do { unsigned _sp = 0; while (cond) { __builtin_amdgcn_s_sleep(1); \
    if ((++_sp & 255u) == 0u) { if (xb_ld(&(bar)[XB_TMO])) break; if (_sp > XB_SPIN_CAP) { atomicAdd(&(bar)[XB_TMO], 1u); break; } } } } while (0)

struct XcdBarrier {
    unsigned* bar; unsigned x;
    volatile LAS unsigned* st;
};

__device__ __forceinline__ XcdBarrier xcd_barrier_post(unsigned* bar, volatile LAS unsigned* st) {
    XcdBarrier b; b.bar = bar; b.x = xb_xcc_id(); b.st = st;
    if (threadIdx.x == 0) (void)xb_add(&bar[XB_XCNT(b.x)], 1u);
    return b;
}
__device__ __forceinline__ void xcd_barrier_complete(unsigned* bar, unsigned x, unsigned& nloc, unsigned& nx) {
    const unsigned G = gridDim.x * gridDim.y * gridDim.z;
    unsigned sum, cnt, mine, sp = 0u;
    for (;;) {
        sum = 0u; cnt = 0u; mine = 0u;
#pragma unroll
        for (unsigned j = 0; j < 16; ++j) { const unsigned c = xb_ld(&bar[XB_XCNT(j)]); sum += c; cnt += (c > 0u) ? 1u : 0u; mine = (j == x) ? c : mine; }
        if (sum == G) break;
        __builtin_amdgcn_s_sleep(1);
        if ((++sp & 255u) == 0u) { if (xb_ld(&bar[XB_TMO])) break; if (sp > XB_SPIN_CAP) { atomicAdd(&bar[XB_TMO], 1u); break; } }
    }
    nloc = mine > 0u ? mine : 1u; nx = cnt > 0u ? cnt : 1u;
}

__device__ __forceinline__ void xcd_barrier(const XcdBarrier& b) {
    asm volatile("s_waitcnt vmcnt(0)" ::: "memory");
    __syncthreads();
    if (threadIdx.x == 0) {
        unsigned* bar = b.bar;
        __builtin_amdgcn_s_waitcnt(0);
        unsigned nloc = b.st[0], nx = b.st[1];
        if (nloc == 0u) { xcd_barrier_complete(bar, b.x, nloc, nx); b.st[0] = nloc; b.st[1] = nx; }
        const unsigned old = xb_add(&bar[XB_XSUB(b.x)], 1u);
        const unsigned gen = old / nloc;
        if (old + 1u == (gen + 1u) * nloc) {
            __builtin_amdgcn_fence(__ATOMIC_RELEASE, "agent");
            asm volatile("s_waitcnt vmcnt(0)" ::: "memory");
            const unsigned og = xb_add(&bar[XB_TOP], 1u);
            const unsigned tg = og / nx;
            if (og + 1u == (tg + 1u) * nx) xb_add(&bar[XB_TOPGEN], 1u);
            else XB_SPIN(xb_ld(&bar[XB_TOPGEN]) == tg, bar);
            __builtin_amdgcn_fence(__ATOMIC_ACQUIRE, "agent");
            xb_add(&bar[XB_XGEN(b.x)], 1u);
            asm volatile("s_waitcnt vmcnt(0)" ::: "memory");
        } else {
            XB_SPIN(xb_ld(&bar[XB_XGEN(b.x)]) == gen, bar);
            __builtin_amdgcn_fence(__ATOMIC_ACQUIRE, "agent");
            asm volatile("s_waitcnt vmcnt(0)" ::: "memory");
        }
    }
    __syncthreads();
}

#ifndef CONV_SPREAD
#define CONV_SPREAD 6
#endif
#ifndef DUPMASK
#define DUPMASK 0
#endif
__device__ __forceinline__ void attn_item(const Params& p, int layer, int it, LAS unsigned char* lds, char* lds_g) {
    using attn_body::bf16;
    const bf16* P = (const bf16*)(p.ws + WS_P);
    int a = it - (layer == 0 ? 170 : 160), b, vh, qrow, nt; bool isA;
    if (a < 1024) { isA = a < 512; a &= 511; b = a >> 6; vh = (a >> 3) & 7; qrow = CTXL + (a & 7) * 256; nt = TOK / 64; }
    else { a -= 1024; isA = a < 64; a &= 63; b = a >> 3; vh = a & 7; qrow = 0; nt = CTXL / 64; }
    const size_t krow = (size_t)b * TOK, row0 = krow + qrow;
    if (isA) { const int h = vh >> 1, j = vh & 1;
        attn_body::attn_unit128<8>(P + row0 * NPROJ + PC_AQ + h * 128 + j * 64, P + krow * NPROJ + PC_AK + h * 128 + j * 64, P + krow * NPROJ + PC_AV + h * 128,
                                   (bf16*)(p.ws + WS_OAP) + row0 * 1024 + h * 256 + j * 128, 1024, nt, lds_g); }
    else { const int hq = vh;
        attn_body::attn_unit<8>(P + row0 * NPROJ + PC_BQ + hq * 64, P + krow * NPROJ + PC_BK + (hq >> 2) * 64, P + krow * NPROJ + PC_BV + (hq >> 2) * 64,
                                (bf16*)(p.ws + WS_OABC) + row0 * 1536 + 512 + hq * 64, 1536, nt, lds_g); }
}

template <int PH>
__device__ __forceinline__ void run_phase(const Params& p, int layer, LAS unsigned char* lds, char* lds_g) {
    unsigned char* ws = p.ws; const int G = gridDim.x, bx = blockIdx.x;
    if constexpr (PH == 0) prologue(p, lds);
    if constexpr (PH == 1) rowpass<0>(p, layer, lds);
    if constexpr (PH == 2) {
        {
            pg8::Gemm g{(const bf16_t*)(ws + WS_H), (const bf16_t*)(ws + WS_WIN) + (size_t)layer * NPROJ * 1024, 1024, 1024, 1024};
            pg8::OrderInProj S; S.init(layer, G, bx);
            const float* cosT = (const float*)(ws + WS_ROPE);
            pg8::EpiInProj E{(bf16_t*)(ws + WS_P), cosT, cosT + LAT * 32, p.qnw + layer * 64, p.knw + layer * 64};
            pg8::gemm_phase(lds, g, S, E);
        }
        {
            pg8::Gemm g{(const bf16_t*)(ws + WS_H8IN), (const bf16_t*)(ws + WS_WG8 + (size_t)layer * 3072 * 1024), 512, 512, 512};
            pg8::OrderGates S; S.init(layer, G, bx);
            pg8::EpiGates E{(bf16_t*)(ws + WS_P)};
            pg8::gemm_phase<false, true>(lds, g, S, E);
        }
    }
    if constexpr (PH == 3) {
#ifndef CONVDUP
#define CONVDUP 1
#endif
        const int ncv1 = layer == 0 ? 106 : 96, ncv = ncv1 * CONVDUP, nit = 64 + ncv + 1024 + (layer == 0 ? 128 : 0);
        unsigned* head = (unsigned*)(ws + WS_CTL) + CW_QUEUE + 64 * layer;
        volatile LAS unsigned* slot = (volatile LAS unsigned*)(lds + DYN_LDS_BYTES - 32);
        bool first = true;
        for (;;) {
            if (threadIdx.x == 0) *slot = first ? (unsigned)bx : (unsigned)G + __hip_atomic_fetch_add(head, 1u, __ATOMIC_RELAXED, __HIP_MEMORY_SCOPE_AGENT);
            first = false;
            __syncthreads();
            const int it = (int)*slot;
            __syncthreads();
            if (it >= nit) break;
            const int pq = it - 64, gq = pq / CONV_SPREAD, rq = pq - gq * CONV_SPREAD;
            if (it < 64) { ml::mlstm_item(p, layer, it, lds); }
            else if (gq < ncv && rq == 0) { const int k = gq % ncv1; convert_item(p, lds, k < 96 ? layer * TR_BG_L0 + k * 256 : TR_BG_ITEMS + (k - 96) * 256); }
            else { const int ai = (gq < ncv) ? pq - (gq + 1) : pq - ncv; attn_item(p, layer, 64 + ncv1 + ai, lds, lds_g); }
        }
    }
    if constexpr (PH == 4) postmix(p, layer);
    if constexpr (PH == 5) {
        const int lo = layer == 1;
        pg8::Gemm g{(const bf16_t*)(ws + WS_OABC), (const bf16_t*)(ws + WS_WBR) + (size_t)layer * 1024 * 1536, 1536, 1536, 1536};
        pg8::Order<pg8::MapDense, 4> S; S.init(lo ? 64 : 72, 4, G, bx, pg8::MapDense{lo});
        pg8::EpiMerge E{(const bf16_t*)(ws + WS_P), (bf16_t*)(ws + WS_MERGED)};
        pg8::gemm_phase(lds, g, S, E);
    }
    if constexpr (PH == 6) {
        const int lo = layer == 1;
        pg8::Gemm g{(const bf16_t*)(ws + WS_MERGED), (const bf16_t*)(ws + WS_WOUT) + (size_t)layer * 1024 * 1024, 1024, 1024, 1024};
        pg8::Order<pg8::MapDense, 4> S; S.init(lo ? 64 : 72, 4, G, bx, pg8::MapDense{lo});
        pg8::EpiOut E{p.x, p.ctx, (bf16_t*)(ws + WS_XR), (const float*)(ws + WS_MOD) + (size_t)layer * 9 * 6144, layer};
        pg8::gemm_phase(lds, g, S, E);
    }
    if constexpr (PH == 7) rowpass<1>(p, layer, lds);
    if constexpr (PH == 8) { const int nit = layer == 0 ? 256 : 128; for (int it = bx; it < nit; it += G) topk_item(p, it, lds);
    }
    if constexpr (PH == 9) {
        const int T = layer == 0 ? 9 : 8;
        pg8::Gemm g{(const bf16_t*)(ws + WS_H), (const bf16_t*)(ws + WS_WGU + (size_t)layer * NE * 4096 * 1024), 512, 512, 512, (const int*)(ws + WS_XIDX)};
        pg8::Order<pg8::MapFFN, 16> S; S.init(NE * T, 16, G, bx, pg8::MapFFN{T, 4096});
        pg8::EpiGateUp E{ws + WS_ACT};
        pg8::gemm_phase<true, true>(lds, g, S, E);
    }
    if constexpr (PH == 10) {
        const int T = layer == 0 ? 9 : 8;
        pg8::Gemm g{(const bf16_t*)(ws + WS_ACT), (const bf16_t*)(ws + WS_WDN + (size_t)layer * NE * 1024 * 2048), 1024, 1024, 1024};
        pg8::Order<pg8::MapFFN, 4> S; S.init(NE * T, 4, G, bx, pg8::MapFFN{T, 1024});
        pg8::EpiDown E{(bf16_t*)(ws + WS_YE), (const float*)(ws + WS_GSEL)};
        pg8::gemm_phase<false, true>(lds, g, S, E);
    }
    if constexpr (PH == 11) { if (layer == 0) rowpass<2>(p, layer, lds); else rowpass<3>(p, layer, lds); }
}

#ifndef MEGA
#define MEGA 1
#endif
#if MEGA
#define GRID_SYNC() xcd_barrier(bar)
#define RUN(PH, layer) do { _Pragma("unroll 1") for (int rep_ = 0; rep_ < 1 + ((DUPMASK >> PH) & 1); ++rep_) { run_phase<PH>(p, layer, lds, lds_g); GRID_SYNC(); } } while (0)
__global__ void __launch_bounds__(NTHREADS, 2) k_mega(Params p) {
    extern __shared__ __attribute__((aligned(16))) unsigned char lds_raw[];
    LAS unsigned char* lds = (LAS unsigned char*)lds_raw; char* lds_g = (char*)lds_raw;
    volatile LAS unsigned* bst = (volatile LAS unsigned*)(lds + DYN_LDS_BYTES - 64);
    if (threadIdx.x < 16) bst[threadIdx.x] = 0u;
    __syncthreads();
    const XcdBarrier bar = xcd_barrier_post((unsigned*)(p.ws + WS_CTL) + CW_BAR, bst);
    RUN(0, 0);
    RUN(1, 0);
#pragma unroll 1
    for (int layer = 0; layer < 2; ++layer) {
        RUN(2, layer);
        RUN(3, layer);
        RUN(4, layer);
        RUN(5, layer);
        RUN(6, layer);
        RUN(7, layer);
        RUN(8, layer);
        RUN(9, layer);
        RUN(10, layer);
        RUN(11, layer);
    }
}
#else
template <int PH> __global__ void __launch_bounds__(NTHREADS, 2) k_phase(Params p, int layer) {
    extern __shared__ __attribute__((aligned(16))) unsigned char lds_raw[];
    run_phase<PH>(p, layer, (LAS unsigned char*)lds_raw, (char*)lds_raw);
}
template <int PH> static void launch_phase(const Params& p, int layer, int grid, hipStream_t stream) {
    static bool attr = false;
    if (!attr) { (void)hipFuncSetAttribute((const void*)k_phase<PH>, hipFuncAttributeMaxDynamicSharedMemorySize, DYN_LDS_BYTES); attr = true; }
    hipLaunchKernelGGL(k_phase<PH>, dim3(grid), dim3(NTHREADS), DYN_LDS_BYTES, stream, p, layer);
}
#endif

extern "C" void kernel_launch(void* const* d_in, const int* in_sizes, int n_in, void* d_out, int out_size, void* d_ws, size_t ws_size, hipStream_t stream) {
    static int grid = 0;
    if (grid == 0) {
        if (n_in != 25 || ws_size < WS_END) { fprintf(stderr, "kernel_launch: expected 25 inputs and >= %zu bytes of workspace, got %d / %zu\n", (size_t)WS_END, n_in, ws_size); grid = -1; return; }
        int dev = 0, cus = 0; (void)hipGetDevice(&dev); (void)hipDeviceGetAttribute(&cus, hipDeviceAttributeMultiprocessorCount, dev);
        if (cus <= 0) cus = 256;
#if MEGA
        int per_cu = 0;
        if (hipFuncSetAttribute((const void*)k_mega, hipFuncAttributeMaxDynamicSharedMemorySize, DYN_LDS_BYTES) != hipSuccess) { fprintf(stderr, "kernel_launch: hipFuncSetAttribute failed\n"); grid = -1; return; }
        if (hipOccupancyMaxActiveBlocksPerMultiprocessor(&per_cu, (const void*)k_mega, NTHREADS, DYN_LDS_BYTES) != hipSuccess || per_cu < 1) { fprintf(stderr, "kernel_launch: occupancy query says %d blocks per CU\n", per_cu); (void)hipGetLastError(); per_cu = 1; }
        grid = cus * 1;
#else
        grid = cus;
#endif
    }
    if (grid < 0) return;
    Params p{};
    const float** pp = (const float**)&p;
    for (int i = 0; i < 25; ++i) pp[i] = (const float*)d_in[i];
    p.out = (float*)d_out; p.ws = (unsigned char*)d_ws;
    (void)hipMemsetAsync((char*)d_ws + WS_CTL, 0, CTL_BYTES, stream);
#if MEGA
    hipLaunchKernelGGL(k_mega, dim3(grid), dim3(NTHREADS), DYN_LDS_BYTES, stream, p);
#else
    launch_phase<0>(p, 0, grid, stream);
    launch_phase<1>(p, 0, grid, stream);
    for (int layer = 0; layer < 2; ++layer) {
        launch_phase<2>(p, layer, grid, stream);
        launch_phase<3>(p, layer, grid, stream);
        launch_phase<4>(p, layer, grid, stream);
        launch_phase<5>(p, layer, grid, stream);
        launch_phase<6>(p, layer, grid, stream);
        launch_phase<7>(p, layer, grid, stream);
        launch_phase<8>(p, layer, grid, stream);
        launch_phase<9>(p, layer, grid, stream);
        launch_phase<10>(p, layer, grid, stream);
        launch_phase<11>(p, layer, grid, stream);
    }
#endif
}
```

```cpp
#include <hip/hip_runtime.h>
#include <hip/hip_cooperative_groups.h>
#include <hip/hip_bf16.h>
#include <cmath>
#include <cstdio>
#include <cstdint>
namespace cg = cooperative_groups;

#define LAS __attribute__((address_space(3)))
typedef unsigned short bf16_t;
typedef short bf16x8 __attribute__((ext_vector_type(8)));
typedef short s16x4 __attribute__((ext_vector_type(4)));
typedef float f32x2 __attribute__((ext_vector_type(2)));
typedef float f32x4 __attribute__((ext_vector_type(4)));
typedef float f32x16 __attribute__((ext_vector_type(16)));
typedef unsigned u32x2 __attribute__((ext_vector_type(2)));
typedef unsigned u32x4 __attribute__((ext_vector_type(4)));
typedef __bf16 bf16x2_t __attribute__((ext_vector_type(2)));

constexpr int NB = 8, LAT = 2048, CTXL = 256, TOK = CTXL + LAT  , ROWS = NB * TOK  ;
constexpr int DM = 1024, MIXW = 512, NPROJ = 7424  , INCOLS = 7440, NE = 16, FF = 2048;
constexpr int GRIDW = 64;
constexpr float EPS = 1e-6f;
constexpr float C2 = 0.125f * 1.4426950408889634f;
constexpr int PC_AQ = 0, PC_AK = 512, PC_AV = 1024, PC_BQ = 1536, PC_BK = 2048, PC_BV = 2176, PC_CQ = 2304, PC_CK = 2816, PC_CV = 3328, PC_CO = 3840, PC_MG = 4352;
constexpr int NTHREADS = 512, NWAVES = 8;
constexpr int DYN_LDS_BYTES = 155648;

constexpr size_t MiB = (size_t)1 << 20;
constexpr size_t WS_CTL = 0, CTL_BYTES = 1 * MiB;
constexpr size_t WS_MOD = 1 * MiB;
constexpr size_t WS_ROPE = 2 * MiB;
constexpr size_t WS_GATES = 3 * MiB;
constexpr size_t WS_AFF = 5 * MiB;
constexpr size_t WS_SLOT = 7 * MiB;
constexpr size_t WS_GSEL = 9 * MiB;
constexpr size_t WS_WIN = 16 * MiB;
constexpr size_t WS_WBR = 46 * MiB;
constexpr size_t WS_WOUT = 52 * MiB;
constexpr size_t WS_WGU = 56 * MiB;
constexpr size_t WS_WG8 = 184 * MiB;
constexpr size_t WS_WDN = 312 * MiB;
constexpr size_t WS_XR = 440 * MiB;
constexpr size_t WS_H8IN = 476 * MiB;
constexpr size_t WS_H = 512 * MiB;
constexpr size_t WS_P = 548 * MiB;
constexpr size_t WS_OAP = 809 * MiB;
constexpr size_t WS_HF = 845 * MiB;
constexpr size_t WS_MP = WS_HF;
constexpr size_t WS_OABC = 917 * MiB;
constexpr size_t WS_MERGED = 971 * MiB;
constexpr size_t WS_XIDX = 548 * MiB;
constexpr size_t WS_ACT = 620 * MiB;
constexpr size_t WS_YE = 764 * MiB;
constexpr size_t WS_END = 1007 * MiB;
static_assert(WS_P + (size_t)ROWS * NPROJ * 2 <= WS_OAP && WS_MERGED + (size_t)ROWS * 1024 * 2 <= WS_END && WS_YE + (size_t)36864 * 1024 * 2 <= WS_HF, "ws map");
constexpr int CW_BAR = 4096;
constexpr int CW_PHDONE = 512;
constexpr int CW_TRQ = 256;
constexpr int CW_QUEUE = 64;

struct Params {
    const float *x, *c, *ctx, *c_ctx, *w_ada, *b_ada, *norm1_w, *norm2_w, *w_in, *conv_w, *gate_b, *mnorm_w, *dlam, *subln_w, *qnw, *knw,
                *wbr_a, *wbr_b, *wbr_c, *w_out, *w_router, *wg, *wu, *wd, *final_w;
    float* out; unsigned char* ws;
};

__device__ __forceinline__ unsigned cvtpk(float lo, float hi) { f32x2 v = {lo, hi}; bf16x2_t b = __builtin_convertvector(v, bf16x2_t); return __builtin_bit_cast(unsigned, b); }
__device__ __forceinline__ unsigned cvt4_fp8(float a, float b, float c, float d) {
    int w = 0;
    w = __builtin_amdgcn_cvt_pk_fp8_f32(__builtin_amdgcn_fmed3f(a, -448.f, 448.f), __builtin_amdgcn_fmed3f(b, -448.f, 448.f), w, false);
    w = __builtin_amdgcn_cvt_pk_fp8_f32(__builtin_amdgcn_fmed3f(c, -448.f, 448.f), __builtin_amdgcn_fmed3f(d, -448.f, 448.f), w, true);
    return (unsigned)w;
}
__device__ __forceinline__ unsigned cvt4_fp8_nc(float a, float b, float c, float d) { int w = 0; w = __builtin_amdgcn_cvt_pk_fp8_f32(a, b, w, false); w = __builtin_amdgcn_cvt_pk_fp8_f32(c, d, w, true); return (unsigned)w; }
constexpr float F8_YSCALE = 16.0f;
constexpr float F8_WSCALE = 32.0f, F8_ASCALE = 4.0f;
__device__ __forceinline__ float bf2f(unsigned short b) { return __uint_as_float(((unsigned)b) << 16); }
__device__ __forceinline__ float bflo(unsigned w) { return __uint_as_float(w << 16); }
__device__ __forceinline__ float bfhi(unsigned w) { return __uint_as_float(w & 0xffff0000u); }
__device__ __forceinline__ float wave_sum(float v) {
#pragma unroll
    for (int o = 1; o < 64; o <<= 1) v += __shfl_xor(v, o);
    return v;
}
__device__ __forceinline__ float fast_sigmoid(float x) { return __builtin_amdgcn_rcpf(1.0f + __builtin_amdgcn_exp2f(-1.4426950408889634f * x)); }
__device__ __forceinline__ float fast_silu(float x) { return x * fast_sigmoid(x); }
__device__ __forceinline__ int opaque_tid() { int t = threadIdx.x; asm volatile("" : "+v"(t)); return t; }
#define LDS_WAIT() asm volatile("s_waitcnt lgkmcnt(0)" ::: "memory")
#define VM_WAIT() asm volatile("s_waitcnt vmcnt(0)" ::: "memory")
typedef int v8i_t __attribute__((ext_vector_type(8)));
namespace pg8 {
constexpr int BM = 256, BK = 64, HALF = 128, HTB = HALF * BK * 2, STAGE_BYTES = 8 * HTB, NXCD = 8, WGM = 8;
__host__ __device__ __forceinline__ int lds_byte(int r, int c) { const int st = (r >> 4) * 2 + (c >> 5), rr = r & 15, cc = c & 31, ob = rr * 64 + cc * 2; return st * 1024 + (ob ^ (((ob >> 9) & 1) << 5)); }
__host__ __device__ __forceinline__ void stage_rc(int b, int& R, int& C) { const int st = b / 1024, sb = b % 1024, swz = sb ^ (((sb >> 9) & 1) << 5); R = (st >> 1) * 16 + swz / 64; C = (st & 1) * 32 + (swz % 64) / 2; }

struct Unit { int pm, pn, arow, brow; };
struct Gemm { const bf16_t* A; const bf16_t* Bt; int lda, ldb, K; const int* gidx; };

template <class Map, int NN> struct Order {
    int nM, nN, nwg, G, c, wgm; Map map;
    __device__ void init(int nM_, int nN_, int G_, int c_, const Map& m, int wgm_ = WGM) { nM = nM_; nN = NN; nwg = nM * NN; G = G_; c = c_; map = m; wgm = wgm_; (void)nN_; }
    __device__ bool next(int i, Unit& u) const { return at(i * G + c, u); }
    __device__ bool at(int L, Unit& u) const {
        if (L >= nwg) return false;
        int wgid = L; { const int q = nwg / NXCD, r = nwg % NXCD, xcd = wgid % NXCD, off = wgid / NXCD; wgid = (xcd < r ? xcd * (q + 1) : r * (q + 1) + (xcd - r) * q) + off; }
        constexpr int nig = WGM * NN; const int gid = wgid / nig, wl = wgid - gid * nig, fm = gid * WGM, gsz = (nM - fm) < WGM ? (nM - fm) : WGM;
        if (gsz == WGM) { u.pm = fm + (wl & (WGM - 1)); u.pn = wl / WGM; } else { u.pm = fm + wl % gsz; u.pn = wl / gsz; }
        u.arow = map.arow(u.pm); u.brow = map.brow(u.pm, u.pn); return true;
    }
};
struct MapDense {
    int latent_only;
    __device__ int arow(int pm) const { return latent_only ? ((pm >> 3) * 9 + 1 + (pm & 7)) * 256 : pm * 256; }
    __device__ int brow(int, int pn) const { return pn * 256; }
};
struct MapFFN {
    int T, nbe;
    __device__ int arow(int pm) const { const int e = (T == 8) ? (pm >> 3) : pm / 9; return (e * 9 + (pm - e * T)) * 256; }
    __device__ int brow(int pm, int pn) const { const int e = (T == 8) ? (pm >> 3) : pm / 9; return e * nbe + pn * 256; }
};

struct OrderGates {
    Order<MapDense, 12> base; int c, first, nshort, ushort_, ulong_, bal;
    __device__ void init(int layer, int G_, int c_) {
        base.init(layer ? 64 : 72, 12, G_, (c_ + 56) % G_, MapDense{layer});
        c = c_; first = 200; nshort = G_ - first; ushort_ = 5; ulong_ = 3; bal = (layer == 0 && G_ == 256);
    }
    __device__ bool next(int i, Unit& u) const {
        if (!bal) return base.next(i, u);
        if (c >= first) { if (i >= ushort_) return false; return base.at((c - first) + nshort * i, u); }
        if (i >= ulong_) return false; return base.at(ushort_ * nshort + c + first * i, u);
    }
};

struct OrderInProj {
    Order<MapDense, 17> base; int extra;
    __device__ void init(int layer, int G_, int c_) { if (layer == 0) { base.init(72, 17, G_, c_, MapDense{0}); extra = 0; } else { base.init(64, 17, G_, c_, MapDense{1}); extra = 88; } }
    __device__ bool next(int i, Unit& u) const {
        if (base.next(i, u)) return true;
        const int idx = i * base.G + base.c - base.nwg; if (idx >= extra) return false;
        const int b = idx / 11, j = idx % 11; u.pm = b * 9; u.pn = (j < 4) ? 2 + j : (j == 4 ? 8 : 4 + j); u.arow = b * 9 * 256; u.brow = u.pn * 256; return true;
    }
};

template <bool GATHER = false, bool FP8 = false, class Epi, class Sched>
__device__ __forceinline__ void gemm_phase(LAS unsigned char* lds, const Gemm g, const Sched& S, const Epi& E) {
    const int tid = opaque_tid(), wid = __builtin_amdgcn_readfirstlane(tid >> 6), lane = tid & 63, wr = wid >> 2, wc = wid & 3, fr = lane & 15, fq = lane >> 4;
    const int K = g.K, nt = K / BK;
    unsigned voffA[2], voffB[2];
#pragma unroll
    for (int i = 0; i < 2; ++i) { int R, C; stage_rc(tid * 16 + i * 8192, R, C); voffA[i] = (unsigned)(R * g.lda + C) * 2u; voffB[i] = (unsigned)(R * g.ldb + C) * 2u; }
    const size_t kstep = (size_t)(BK * 2);
    const size_t hstepA = (size_t)HALF * g.lda * 2, hstepB = (size_t)HALF * g.ldb * 2;
    const unsigned ldsw = (unsigned)wid * 1024u;
    const int aoff = lds_byte(wr * 64 + fr, fq * 8), boff = lds_byte(wc * 32 + fr, fq * 8);
#define PG8_SA(b, h) (((b) * 2 + (h)) * HTB)
#define PG8_SB(b, h) ((4 + (b) * 2 + (h)) * HTB)
#define PG8_STAGE(bufoff, gbase, voff) do { _Pragma("unroll") for (int _i = 0; _i < 2; ++_i) \
        __builtin_amdgcn_global_load_lds((const unsigned*)((const char*)(gbase) + (voff)[_i]), (LAS unsigned*)(lds + (bufoff) + ldsw + _i * 8192), 16, 0, 0); } while (0)
    unsigned vAc[2][2], vAn[2][2]; int gi[2][2];
#define PG8_GI_ISSUE(ar) do { _Pragma("unroll") for (int _h = 0; _h < 2; ++_h) _Pragma("unroll") for (int _i = 0; _i < 2; ++_i) { int R_, C_; stage_rc(tid * 16 + _i * 8192, R_, C_); gi[_h][_i] = g.gidx[(ar) + _h * HALF + R_]; } } while (0)
#define PG8_GI_ISSUE_ASM(ar) do { _Pragma("unroll") for (int _h = 0; _h < 2; ++_h) _Pragma("unroll") for (int _i = 0; _i < 2; ++_i) { int R_, C_; stage_rc(tid * 16 + _i * 8192, R_, C_); const int* ip_ = g.gidx + ((ar) + _h * HALF + R_); \
        asm volatile("global_load_dword %0, %1, off" : "=v"(gi[_h][_i]) : "v"(ip_) : "memory"); } } while (0)
#define PG8_GI_CONV(v) do { _Pragma("unroll") for (int _h = 0; _h < 2; ++_h) _Pragma("unroll") for (int _i = 0; _i < 2; ++_i) { int R_, C_; stage_rc(tid * 16 + _i * 8192, R_, C_); v[_h][_i] = (unsigned)(gi[_h][_i] * g.lda + C_) * 2u; } } while (0)
#define PG8_STA(bufoff, basep, kb, nx, h) do { if constexpr (GATHER) { const char* gb_ = (const char*)g.A + (kb); _Pragma("unroll") for (int _i = 0; _i < 2; ++_i) { const unsigned vo_ = (nx) ? vAn[h][_i] : vAc[h][_i]; \
        __builtin_amdgcn_global_load_lds((const unsigned*)(gb_ + vo_), (LAS unsigned*)(lds + (bufoff) + ldsw + _i * 8192), 16, 0, 0); } } else PG8_STAGE(bufoff, basep, voffA); } while (0)
#define PG8_LDA(dst, b, h) do { _Pragma("unroll") for (int m = 0; m < 4; ++m) _Pragma("unroll") for (int k = 0; k < 2; ++k) dst[m][k] = *(const LAS bf16x8*)(lds + PG8_SA(b, h) + aoff + m * 2048 + k * 1024); } while (0)
#define PG8_LDB(dst, b, h) do { _Pragma("unroll") for (int n = 0; n < 2; ++n) _Pragma("unroll") for (int k = 0; k < 2; ++k) dst[n][k] = *(const LAS bf16x8*)(lds + PG8_SB(b, h) + boff + n * 2048 + k * 1024); } while (0)
#define PG8_CAT(x0, x1) ({ const u32x4 p_ = __builtin_bit_cast(u32x4, x0), q_ = __builtin_bit_cast(u32x4, x1); (v8i_t){(int)p_.x, (int)p_.y, (int)p_.z, (int)p_.w, (int)q_.x, (int)q_.y, (int)q_.z, (int)q_.w}; })
#define PG8_MMA(ai, bj, At, Bt) do { __builtin_amdgcn_s_setprio(1); if constexpr (FP8) { v8i_t a8_[4], b8_[2]; _Pragma("unroll") for (int m = 0; m < 4; ++m) a8_[m] = PG8_CAT(At[m][0], At[m][1]); \
        _Pragma("unroll") for (int n = 0; n < 2; ++n) b8_[n] = PG8_CAT(Bt[n][0], Bt[n][1]); \
        _Pragma("unroll") for (int m = 0; m < 4; ++m) _Pragma("unroll") for (int n = 0; n < 2; ++n) asm volatile("v_mfma_f32_16x16x128_f8f6f4 %0, %1, %2, %0" : "+v"(acc[ai][bj][m][n]) : "v"(b8_[n]), "v"(a8_[m])); } else { \
        _Pragma("unroll") for (int m = 0; m < 4; ++m) _Pragma("unroll") for (int n = 0; n < 2; ++n) _Pragma("unroll") for (int k = 0; k < 2; ++k) \
        acc[ai][bj][m][n] = __builtin_amdgcn_mfma_f32_16x16x32_bf16(Bt[n][k], At[m][k], acc[ai][bj][m][n], 0, 0, 0); } __builtin_amdgcn_s_setprio(0); } while (0)
#define PG8_WAIT_V(n) asm volatile("s_waitcnt vmcnt(" #n ")" ::: "memory")
#define PG8_WAIT_L(n) asm volatile("s_waitcnt lgkmcnt(" #n ")" ::: "memory")
#define PG8_BAR __builtin_amdgcn_s_barrier()
#define PG8_SCHED __builtin_amdgcn_sched_barrier(0)
    Unit cur, nxt; int ui = 0;
    if (!S.next(0, cur)) return;
    f32x4 acc[2][2][4][2];
#pragma unroll
    for (int a = 0; a < 2; ++a)
#pragma unroll
        for (int b = 0; b < 2; ++b)
#pragma unroll
            for (int m = 0; m < 4; ++m)
#pragma unroll
                for (int n = 0; n < 2; ++n) acc[a][b][m][n] = (f32x4){0.f, 0.f, 0.f, 0.f};
    bf16x8 At[4][2], B0[2][2], B1[2][2];
    const char* cA = (const char*)g.A + (size_t)cur.arow * g.lda * 2; const char* cB = (const char*)g.Bt + (size_t)cur.brow * g.ldb * 2;
    if constexpr (GATHER) { PG8_GI_ISSUE(cur.arow); PG8_GI_CONV(vAc); Unit u1; const bool h1 = S.next(1, u1); const int ar1 = h1 ? u1.arow : cur.arow; PG8_GI_ISSUE(ar1); PG8_GI_CONV(vAn); }
    PG8_STAGE(PG8_SB(0, 0), cB, voffB); PG8_STAGE(PG8_SB(0, 1), cB + hstepB, voffB); PG8_STA(PG8_SA(0, 0), cA, 0, false, 0); PG8_STA(PG8_SA(0, 1), cA + hstepA, 0, false, 1);
    if (wr == 1) PG8_BAR;
    PG8_WAIT_V(2); PG8_BAR;
    PG8_STAGE(PG8_SB(1, 0), cB + kstep, voffB); PG8_STA(PG8_SA(1, 0), cA + kstep, kstep, false, 0); PG8_STAGE(PG8_SB(1, 1), cB + hstepB + kstep, voffB);
    PG8_WAIT_V(6); PG8_BAR;
    for (;;) {
        const bool has_next = S.next(ui + 1, nxt);
        const char* nA = has_next ? (const char*)g.A + (size_t)nxt.arow * g.lda * 2 : cA; const char* nB = has_next ? (const char*)g.Bt + (size_t)nxt.brow * g.ldb * 2 : cB;
#pragma unroll 1
        for (int t = 0; t < nt; t += 2) {
            if constexpr (Epi::HAS_MID) { if (E.mid_at(t)) E.mid(acc, cur, t, wr, wc, fr, fq); }
            const bool last = (t == nt - 2);
            const char* a1 = cA + (size_t)(t + 1) * kstep;
            const char* a2 = last ? nA : cA + (size_t)(t + 2) * kstep; const char* b2 = last ? nB : cB + (size_t)(t + 2) * kstep;
            const char* a3 = a2 + kstep; const char* b3 = b2 + kstep;
            const size_t kb1 = (size_t)(t + 1) * kstep, kb2 = last ? (size_t)0 : (size_t)(t + 2) * kstep;
            PG8_LDB(B0, 0, 0); PG8_LDB(B1, 0, 1); PG8_SCHED; PG8_LDA(At, 0, 0); PG8_STA(PG8_SA(1, 1), a1 + hstepA, kb1, false, 1);
            PG8_WAIT_V(8); PG8_WAIT_L(0); PG8_BAR; PG8_MMA(0, 0, At, B0); PG8_MMA(0, 1, At, B1); PG8_BAR; PG8_SCHED;
            PG8_LDA(At, 0, 1); PG8_STAGE(PG8_SB(0, 0), b2, voffB); PG8_STAGE(PG8_SB(0, 1), b2 + hstepB, voffB); PG8_STA(PG8_SA(0, 0), a2, kb2, last, 0);
            PG8_WAIT_V(8); PG8_WAIT_L(0); PG8_BAR; PG8_MMA(1, 0, At, B0); PG8_MMA(1, 1, At, B1); PG8_BAR; PG8_SCHED;
            PG8_LDB(B0, 1, 0); PG8_LDB(B1, 1, 1); PG8_SCHED; PG8_LDA(At, 1, 0); PG8_STA(PG8_SA(0, 1), a2 + hstepA, kb2, last, 1);
            PG8_WAIT_V(8); PG8_WAIT_L(0); PG8_BAR; PG8_MMA(0, 0, At, B0); PG8_MMA(0, 1, At, B1); PG8_BAR; PG8_SCHED;
            PG8_LDA(At, 1, 1); PG8_STAGE(PG8_SB(1, 0), b3, voffB); PG8_STAGE(PG8_SB(1, 1), b3 + hstepB, voffB); PG8_STA(PG8_SA(1, 0), a3, kb2 + kstep, last, 0);
            PG8_WAIT_V(8); PG8_WAIT_L(0); PG8_BAR; PG8_MMA(1, 0, At, B0); PG8_MMA(1, 1, At, B1); PG8_BAR; PG8_SCHED;
        }
        if (wr == 0) PG8_BAR;
        if constexpr (FP8) { asm volatile("s_nop 15\n\ts_nop 15" ::: "memory"); PG8_SCHED; }
        if constexpr (GATHER) { Unit u2; const bool h2 = S.next(ui + 2, u2); const int ar2 = h2 ? u2.arow : cur.arow; PG8_GI_ISSUE_ASM(ar2); }
        E(acc, cur, wr, wc, fr, fq);
        unsigned vNN[2][2];
        if constexpr (GATHER) { static_assert(!GATHER || Epi::NSTORES == 8, "the counted wait below assumes the epilogue's store count");
            asm volatile("s_waitcnt vmcnt(8)" : "+v"(gi[0][0]), "+v"(gi[0][1]), "+v"(gi[1][0]), "+v"(gi[1][1]) :: "memory");
            PG8_GI_CONV(vNN); }
        if (!has_next) break;
        if constexpr (GATHER) {
#pragma unroll
            for (int h = 0; h < 2; ++h)
#pragma unroll
                for (int i = 0; i < 2; ++i) { vAc[h][i] = vAn[h][i]; vAn[h][i] = vNN[h][i]; } }
#pragma unroll
        for (int a = 0; a < 2; ++a)
#pragma unroll
            for (int b = 0; b < 2; ++b)
#pragma unroll
                for (int m = 0; m < 4; ++m)
#pragma unroll
                    for (int n = 0; n < 2; ++n) acc[a][b][m][n] = (f32x4){0.f, 0.f, 0.f, 0.f};
        cur = nxt; cA = nA; cB = nB; ++ui;
        if (wr == 1) PG8_BAR;
    }
    PG8_WAIT_V(0);
    PG8_BAR;
#undef PG8_SA
#undef PG8_SB
#undef PG8_STAGE
#undef PG8_STA
#undef PG8_GI_ISSUE
#undef PG8_GI_ISSUE_ASM
#undef PG8_GI_CONV
#undef PG8_LDA
#undef PG8_LDB
#undef PG8_MMA
#undef PG8_CAT
#undef PG8_WAIT_V
#undef PG8_WAIT_L
#undef PG8_BAR
#undef PG8_SCHED
}

typedef const f32x4 (&AccRef)[2][2][4][2];

__device__ __forceinline__ u32x4 pack8(f32x4 a, f32x4 b) { u32x4 w; w.x = cvtpk(a[0], a[1]); w.y = cvtpk(a[2], a[3]); w.z = cvtpk(b[0], b[1]); w.w = cvtpk(b[2], b[3]); return w; }

struct EpiInProj {
    static constexpr bool HAS_MID = false;
    bf16_t* P; const float* cosT; const float* sinT; const float* qnw; const float* knw;
    __device__ __forceinline__ void operator()(AccRef acc, const Unit& u, int wr, int wc, int fr, int fq_in) const {
        int fq = fq_in; asm volatile("" : "+v"(fq));
        const int pn = u.pn;
        int kind;
        if (pn < 2) kind = 1; else if (pn < 4) kind = 2; else if (pn < 6) kind = 0; else if (pn < 8) kind = 3; else if (pn == 8) kind = (wc < 2) ? 4 : 0; else if (pn < 15) kind = 0; else kind = 5;
        const int tb = u.arow % TOK;
        const bool lat = tb != 0;
        bf16_t* const pbase = P + (size_t)u.arow * NPROJ + pn * 256 + wc * 64 + fq * 8;
        if (kind == 0 || kind == 5) {
#pragma unroll
            for (int ai = 0; ai < 2; ++ai)
#pragma unroll
                for (int m = 0; m < 4; ++m) {
                    const int rl = ai * HALF + wr * 64 + m * 16 + fr;
#pragma unroll
                    for (int bj = 0; bj < 2; ++bj) {
                        f32x4 a = acc[ai][bj][m][0], b = acc[ai][bj][m][1];
                        if (kind == 5) {
#pragma unroll
                            for (int j = 0; j < 4; ++j) { a[j] = fast_sigmoid(a[j]); b[j] = fast_sigmoid(b[j]); } }
                        *(u32x4*)(pbase + (size_t)rl * NPROJ + bj * 32) = pack8(a, b);
                    }
                }
            return;
        }
        f32x4 nw[2][2];
        { const float* w = (kind == 3) ? qnw : knw;
#pragma unroll
            for (int bj = 0; bj < 2; ++bj)
#pragma unroll
                for (int n = 0; n < 2; ++n) nw[bj][n] = *(const f32x4*)(w + 32 * bj + 8 * fq + 4 * n);
            asm volatile("" :: "v"(nw[0][0]), "v"(nw[0][1]), "v"(nw[1][0]), "v"(nw[1][1])); }
        const int tl0 = lat ? tb - CTXL + wr * 64 + fr : 0, tlm = lat ? 1 : 0;
        constexpr int RB = 2;
#pragma unroll
        for (int r0 = 0; r0 < 8; r0 += RB) {
            f32x4 cs[RB][2], sn[RB][2];
#pragma unroll
            for (int q = 0; q < RB; ++q) { const int rI = r0 + q; const int tl = tl0 + tlm * ((rI >> 2) * HALF + (rI & 3) * 16);
#pragma unroll
                for (int n = 0; n < 2; ++n) { cs[q][n] = *(const f32x4*)(cosT + (size_t)tl * 32 + 8 * fq + 4 * n); sn[q][n] = *(const f32x4*)(sinT + (size_t)tl * 32 + 8 * fq + 4 * n); } }
#pragma unroll
            for (int q = 0; q < RB; ++q) {
                const int rI = r0 + q, ai = rI >> 2, m = rI & 3;
                const int rl = ai * HALF + wr * 64 + m * 16 + fr;
                f32x4 v[2][2];
#pragma unroll
                for (int bj = 0; bj < 2; ++bj)
#pragma unroll
                    for (int n = 0; n < 2; ++n) v[bj][n] = acc[ai][bj][m][n];
                asm volatile("" :: "v"(cs[q][0]), "v"(cs[q][1]), "v"(sn[q][0]), "v"(sn[q][1]));
                if (kind == 3 || kind == 4) {
                    float s = 0.f;
#pragma unroll
                    for (int bj = 0; bj < 2; ++bj)
#pragma unroll
                        for (int n = 0; n < 2; ++n) { const f32x4 x = v[bj][n]; s += (x[0] * x[0] + x[1] * x[1]) + (x[2] * x[2] + x[3] * x[3]); }
                    s += __shfl_xor(s, 16); s += __shfl_xor(s, 32);
                    const float r = rsqrtf(s * (1.0f / 64.0f) + EPS);
#pragma unroll
                    for (int bj = 0; bj < 2; ++bj)
#pragma unroll
                        for (int n = 0; n < 2; ++n) v[bj][n] = v[bj][n] * r * nw[bj][n];
                }
                if (lat) {
#pragma unroll
                    for (int n = 0; n < 2; ++n) { const f32x4 x1 = v[0][n], x2 = v[1][n]; v[0][n] = x1 * cs[q][n] - x2 * sn[q][n]; v[1][n] = x1 * sn[q][n] + x2 * cs[q][n]; }
                }
                if (kind == 1 || kind == 3) {
#pragma unroll
                    for (int bj = 0; bj < 2; ++bj)
#pragma unroll
                        for (int n = 0; n < 2; ++n) v[bj][n] = v[bj][n] * C2;
                }
#pragma unroll
                for (int bj = 0; bj < 2; ++bj) *(u32x4*)(pbase + (size_t)rl * NPROJ + bj * 32) = pack8(v[bj][0], v[bj][1]);
            }
            __builtin_amdgcn_sched_barrier(0);
        }
    }
};

__device__ __forceinline__ unsigned gate_q4(f32x4 g) {
    const unsigned q0 = (unsigned)fmaxf(g[0] * 255.0f + 0.5f, 1.0f), q1 = (unsigned)fmaxf(g[1] * 255.0f + 0.5f, 1.0f), q2 = (unsigned)fmaxf(g[2] * 255.0f + 0.5f, 1.0f), q3 = (unsigned)fmaxf(g[3] * 255.0f + 0.5f, 1.0f);
    return q0 | (q1 << 8) | (q2 << 16) | (q3 << 24);
}
__device__ __forceinline__ f32x4 gate_u4(unsigned w) { return (f32x4){(float)(w & 0xffu), (float)((w >> 8) & 0xffu), (float)((w >> 16) & 0xffu), (float)(w >> 24)}; }
constexpr size_t P_ROWB = (size_t)NPROJ * 2, P_GATEB = (size_t)PC_MG * 2;

struct EpiGates {
    static constexpr bool HAS_MID = false;
    bf16_t* P;
    __device__ __forceinline__ void operator()(AccRef acc, const Unit& u, int wr, int wc, int fr, int fq_in) const {
        int fq = fq_in; asm volatile("" : "+v"(fq));
        unsigned char* const gslab = (unsigned char*)P + (size_t)u.arow * P_ROWB + P_GATEB + u.pn * 256 + wc * 64 + (fq & 1) * 32 + (fq >> 1) * 16;
        constexpr float inv = 1.0f / F8_WSCALE;
#pragma unroll
        for (int ai = 0; ai < 2; ++ai)
#pragma unroll
            for (int m = 0; m < 4; ++m) {
                const int rl = ai * HALF + wr * 64 + m * 16 + fr;
                u32x2 w[2];
#pragma unroll
                for (int bj = 0; bj < 2; ++bj) {
                    f32x4 a = acc[ai][bj][m][0], b = acc[ai][bj][m][1];
#pragma unroll
                    for (int j = 0; j < 4; ++j) { a[j] = __builtin_amdgcn_rcpf(1.0f + __builtin_amdgcn_exp2f(a[j] * (-1.4426950408889634f * inv))); b[j] = __builtin_amdgcn_rcpf(1.0f + __builtin_amdgcn_exp2f(b[j] * (-1.4426950408889634f * inv))); }
                    w[bj] = (u32x2){gate_q4(a), gate_q4(b)};
                }
                const auto rx = __builtin_amdgcn_permlane16_swap(w[0].x, w[1].x, false, false), ry = __builtin_amdgcn_permlane16_swap(w[0].y, w[1].y, false, false);
                *(u32x4*)(gslab + (size_t)rl * P_ROWB) = (u32x4){rx[0], ry[0], rx[1], ry[1]};
            }
    }
};

struct EpiMerge {
    static constexpr bool HAS_MID = true;
    const bf16_t* P; bf16_t* OUT;
    __device__ __forceinline__ bool mid_at(int t) const { return t == 8 || t == 16; }
    template <class Acc> __device__ __forceinline__ void mid(Acc& acc, const Unit& u, int t, int wr, int wc, int fr_in, int fq_in) const {
        int fq = fq_in, fr = fr_in; asm volatile("" : "+v"(fq), "+v"(fr));
        const int br = (t >> 3) - 1;
        const unsigned char* gbase = (const unsigned char*)P + ((size_t)u.arow + wr * 64 + fr) * P_ROWB + P_GATEB + br * 1024 + u.pn * 256 + wc * 64 + fq * 8;
#pragma unroll
        for (int hb = 0; hb < 2; ++hb) {
            u32x2 ga[4][2], gb[4][2];
#pragma unroll
            for (int q = 0; q < 4; ++q) { const unsigned char* rp = gbase + (size_t)(hb * HALF + q * 16) * P_ROWB;
#pragma unroll
                for (int bj = 0; bj < 2; ++bj) { ga[q][bj] = *(const u32x2*)(rp + bj * 32); gb[q][bj] = *(const u32x2*)(rp + bj * 32 + 1024); } }
#pragma unroll
            for (int q = 0; q < 4; ++q)
#pragma unroll
                for (int bj = 0; bj < 2; ++bj) {
                    f32x4 r0 = gate_u4(ga[q][bj].x), r1 = gate_u4(ga[q][bj].y);
                    const f32x4 d0 = gate_u4(gb[q][bj].x), d1 = gate_u4(gb[q][bj].y);
#pragma unroll
                    for (int j = 0; j < 4; ++j) { r0[j] = r0[j] * __builtin_amdgcn_rcpf(d0[j]); r1[j] = r1[j] * __builtin_amdgcn_rcpf(d1[j]); }
                    acc[hb][bj][q][0] = acc[hb][bj][q][0] * r0; acc[hb][bj][q][1] = acc[hb][bj][q][1] * r1;
                }
            __builtin_amdgcn_sched_barrier(0);
        }
    }
    __device__ __forceinline__ void operator()(AccRef acc, const Unit& u, int wr, int wc, int fr, int fq_in) const {
        int fq = fq_in; asm volatile("" : "+v"(fq));
        const size_t r0 = (size_t)u.arow + wr * 64 + fr; const int col0 = u.pn * 256 + wc * 64 + fq * 8;
        const unsigned char* gbase = (const unsigned char*)P + r0 * P_ROWB + P_GATEB + 2 * 1024 + col0; bf16_t* obase = OUT + r0 * 1024 + col0;
        u32x2 gw[8][2];
#pragma unroll
        for (int rI = 0; rI < 8; ++rI)
#pragma unroll
            for (int bj = 0; bj < 2; ++bj) gw[rI][bj] = *(const u32x2*)(gbase + (size_t)((rI >> 2) * HALF + (rI & 3) * 16) * P_ROWB + bj * 32);
#pragma unroll
        for (int rI = 0; rI < 8; ++rI) {
            const int ai = rI >> 2, m = rI & 3; const size_t ro = (size_t)(ai * HALF + m * 16);
#pragma unroll
            for (int bj = 0; bj < 2; ++bj) {
                const f32x4 a = acc[ai][bj][m][0] * (gate_u4(gw[rI][bj].x) * (1.0f / 255.0f)), b = acc[ai][bj][m][1] * (gate_u4(gw[rI][bj].y) * (1.0f / 255.0f));
                *(u32x4*)(obase + ro * 1024 + bj * 32) = pack8(a, b);
            }
        }
    }
};

struct EpiOut {
    static constexpr bool HAS_MID = false;
    const float* xin; const float* ctxin; bf16_t* XR; const float* mod; int layer;
    __device__ __forceinline__ void operator()(AccRef acc, const Unit& u, int wr, int wc, int fr, int fq_in) const {
        int fq = fq_in; asm volatile("" : "+v"(fq));
        const int b = u.arow / TOK, tb = u.arow % TOK; const int bm = (tb == 0) ? 8 : b;
        const int col0 = u.pn * 256 + wc * 64 + fq * 8;
        const float* g1 = mod + (size_t)bm * 6144 + 2048 + col0;
        f32x4 gv[2][2];
#pragma unroll
        for (int bj = 0; bj < 2; ++bj)
#pragma unroll
            for (int n = 0; n < 2; ++n) gv[bj][n] = *(const f32x4*)(g1 + bj * 32 + 4 * n);
        bf16_t* dst0 = XR + ((size_t)u.arow + wr * 64 + fr) * 1024 + col0;
        if (layer == 0) {
            const float* src0 = ((tb == 0) ? ctxin + ((size_t)b * CTXL + wr * 64 + fr) * 1024 : xin + ((size_t)b * LAT + (tb - CTXL) + wr * 64 + fr) * 1024) + col0;
            f32x4 xa[2][2][2];
#pragma unroll
            for (int hb = 0; hb < 4; ++hb) {
#pragma unroll
                for (int q = 0; q < 2; ++q)
#pragma unroll
                    for (int bj = 0; bj < 2; ++bj)
#pragma unroll
                        for (int n = 0; n < 2; ++n) xa[q][bj][n] = *(const f32x4*)(src0 + (size_t)((hb >> 1) * HALF + (2 * (hb & 1) + q) * 16) * 1024 + bj * 32 + 4 * n);
#pragma unroll
                for (int q = 0; q < 2; ++q)
#pragma unroll
                    for (int bj = 0; bj < 2; ++bj) { const int ai = hb >> 1, m = 2 * (hb & 1) + q;
                        *(u32x4*)(dst0 + (size_t)(ai * HALF + m * 16) * 1024 + bj * 32) = pack8(xa[q][bj][0] + gv[bj][0] * acc[ai][bj][m][0], xa[q][bj][1] + gv[bj][1] * acc[ai][bj][m][1]); }
                __builtin_amdgcn_sched_barrier(0);
            }
        } else {
            u32x4 xo[4][2];
#pragma unroll
            for (int hb = 0; hb < 2; ++hb) {
#pragma unroll
                for (int q = 0; q < 4; ++q)
#pragma unroll
                    for (int bj = 0; bj < 2; ++bj) xo[q][bj] = *(const u32x4*)(dst0 + (size_t)(hb * HALF + q * 16) * 1024 + bj * 32);
#pragma unroll
                for (int q = 0; q < 4; ++q)
#pragma unroll
                    for (int bj = 0; bj < 2; ++bj) { const u32x4 w = xo[q][bj];
                        const f32x4 x0 = {bflo(w.x), bfhi(w.x), bflo(w.y), bfhi(w.y)}, x1 = {bflo(w.z), bfhi(w.z), bflo(w.w), bfhi(w.w)};
                        *(u32x4*)(dst0 + (size_t)(hb * HALF + q * 16) * 1024 + bj * 32) = pack8(x0 + gv[bj][0] * acc[hb][bj][q][0], x1 + gv[bj][1] * acc[hb][bj][q][1]); }
                __builtin_amdgcn_sched_barrier(0);
            }
        }
    }
};

struct EpiGateUp {
    static constexpr bool HAS_MID = false; static constexpr int NSTORES = 8;
    unsigned char* ACT;
    __device__ __forceinline__ void operator()(AccRef acc, const Unit& u, int wr, int wc, int fr, int fq_in) const {
        int fq = fq_in; asm volatile("" : "+v"(fq));
        constexpr float inv = 1.0f / F8_WSCALE, invs = F8_ASCALE / F8_WSCALE;
#pragma unroll
        for (int ai = 0; ai < 2; ++ai)
#pragma unroll
            for (int m = 0; m < 4; ++m) {
                const size_t row = (size_t)u.arow + ai * HALF + wr * 64 + m * 16 + fr;
                f32x4 o[2];
#pragma unroll
                for (int n = 0; n < 2; ++n)
#pragma unroll
                    for (int j = 0; j < 4; ++j) o[n][j] = fast_silu(acc[ai][0][m][n][j] * inv) * (acc[ai][1][m][n][j] * invs);
                *(u32x2*)(ACT + row * 2048 + u.pn * 128 + wc * 32 + fq * 8) = (u32x2){cvt4_fp8(o[0][0], o[0][1], o[0][2], o[0][3]), cvt4_fp8(o[1][0], o[1][1], o[1][2], o[1][3])};
            }
    }
};

struct EpiDown {
    static constexpr bool HAS_MID = false;
    unsigned char* YE; const float* GSEL;
    __device__ __forceinline__ void operator()(AccRef acc, const Unit& u, int wr, int wc, int fr, int fq_in) const {
        int fq = fq_in; asm volatile("" : "+v"(fq));
        float gs[8];
#pragma unroll
        for (int rI = 0; rI < 8; ++rI) gs[rI] = GSEL[(size_t)u.arow + (rI >> 2) * HALF + wr * 64 + (rI & 3) * 16 + fr];
        unsigned char* const yslab = YE + (size_t)u.arow * 1024 + u.pn * 256 + wc * 64 + (fq & 1) * 32 + (fq >> 1) * 16;
#pragma unroll
        for (int ai = 0; ai < 2; ++ai)
#pragma unroll
            for (int m = 0; m < 4; ++m) {
                const int rl = ai * HALF + wr * 64 + m * 16 + fr;
                const float g = gs[ai * 4 + m] * (F8_YSCALE / (F8_WSCALE * F8_ASCALE));
                u32x2 w[2];
#pragma unroll
                for (int bj = 0; bj < 2; ++bj) { const f32x4 a = acc[ai][bj][m][0] * g, b = acc[ai][bj][m][1] * g; w[bj] = (u32x2){cvt4_fp8(a[0], a[1], a[2], a[3]), cvt4_fp8(b[0], b[1], b[2], b[3])}; }
                const auto rx = __builtin_amdgcn_permlane16_swap(w[0].x, w[1].x, false, false), ry = __builtin_amdgcn_permlane16_swap(w[0].y, w[1].y, false, false);
                *(u32x4*)(yslab + (size_t)rl * 1024) = (u32x4){rx[0], ry[0], rx[1], ry[1]};
            }
    }
};
}
namespace attn_body {
using bf16=__hip_bfloat16;
using bf16x8=__attribute__((ext_vector_type(8)))short;
using s16x4=__attribute__((ext_vector_type(4)))short;
using f32x16=__attribute__((ext_vector_type(16)))float;
using u32x4=__attribute__((ext_vector_type(4)))unsigned;
constexpr int D=64,DM=7424;
constexpr int NW=8,QBLK=32,QB=QBLK*NW,KVBLK=64;
__device__ __forceinline__ int crow(int r,int hi){return (r&3)+8*(r>>2)+4*hi;}
#define SBAR() __builtin_amdgcn_sched_barrier(0)
__device__ __forceinline__ void cmask(f32x16&p0,f32x16&p1,int jb,int qrel,int hi){
  const float NEG=-INFINITY; int kb=64*jb+4*hi;
  #pragma unroll
  for(int r=0;r<16;++r){int kv=kb+(r&3)+8*(r>>2); if(kv>qrel)p0[r]=NEG; if(kv+32>qrel)p1[r]=NEG;}
}

constexpr int NSLOT=3, SLOTB=8192;
constexpr int LDS_K=0, LDS_V=NSLOT*SLOTB, LDS_WS=2*NSLOT*SLOTB, LDS_OST=LDS_WS+NW*64*4, LDS_BYTES=LDS_OST+NW*4096;
constexpr float C2=0.125f*1.4426950408889634f;
__device__ __forceinline__ void glds16(const void*gsrc,unsigned lds_dst){unsigned keep;
  asm volatile("s_mov_b32 %0, m0\n\ts_mov_b32 m0, %2\n\ts_nop 0\n\tglobal_load_lds_dwordx4 %1, off\n\ts_mov_b32 m0, %0":"=&s"(keep):"v"(gsrc),"s"(lds_dst):"memory");}
__device__ __forceinline__ float max3f(float a,float b,float c){float r;asm("v_max3_f32 %0, %1, %2, %3":"=v"(r):"v"(a),"v"(b),"v"(c));return r;}
__device__ __forceinline__ float max2f(float a,float b){float r;asm("v_max_f32_e32 %0, %1, %2":"=v"(r):"v"(a),"v"(b));return r;}
__device__ __forceinline__ float fadd_s(float a,float b){float r;asm("v_add_f32_e32 %0, %1, %2":"=v"(r):"v"(a),"v"(b));return r;}
__device__ __forceinline__ float fsub_s(float a,float b){float r;asm("v_sub_f32_e32 %0, %1, %2":"=v"(r):"v"(a),"v"(b));return r;}
typedef float f32x2_t __attribute__((ext_vector_type(2))); typedef __bf16 bf16x2_t __attribute__((ext_vector_type(2)));
__device__ __forceinline__ unsigned cvtpk_s(float lo,float hi){f32x2_t v={lo,hi};bf16x2_t b=__builtin_convertvector(v,bf16x2_t);return __builtin_bit_cast(unsigned,b);}
#define WAIT_BAR(N) asm volatile("s_waitcnt vmcnt(" #N ") lgkmcnt(0)\n\ts_barrier":::"memory")

__device__ __forceinline__ void qkt(f32x16&p0,f32x16&p1,const char*Kslot,const bf16x8*qr,const f32x16&negm,int r32,int hi){
  const char*kb=Kslot+hi*1024+r32*16;
  #pragma unroll
  for(int d0=0;d0<4;++d0){
    const bf16x8 b0=*reinterpret_cast<const bf16x8*>(kb+d0*2048);
    const bf16x8 b1=*reinterpret_cast<const bf16x8*>(kb+d0*2048+512);
    if(d0==0){p0=__builtin_amdgcn_mfma_f32_32x32x16_bf16(b0,qr[0],negm,0,0,0);p1=__builtin_amdgcn_mfma_f32_32x32x16_bf16(b1,qr[0],negm,0,0,0);}
    else{p0=__builtin_amdgcn_mfma_f32_32x32x16_bf16(b0,qr[d0],p0,0,0,0);p1=__builtin_amdgcn_mfma_f32_32x32x16_bf16(b1,qr[d0],p1,0,0,0);}}
}
typedef __attribute__((address_space(3))) const char* lds_cptr;
typedef short v4i16_t __attribute__((ext_vector_type(4)));
__device__ __forceinline__ void kload8(bf16x8*kf,lds_cptr kp){
  kf[0]=*(const __attribute__((address_space(3))) bf16x8*)(kp);      kf[1]=*(const __attribute__((address_space(3))) bf16x8*)(kp+512);
  kf[2]=*(const __attribute__((address_space(3))) bf16x8*)(kp+2048); kf[3]=*(const __attribute__((address_space(3))) bf16x8*)(kp+2560);
  kf[4]=*(const __attribute__((address_space(3))) bf16x8*)(kp+4096); kf[5]=*(const __attribute__((address_space(3))) bf16x8*)(kp+4608);
  kf[6]=*(const __attribute__((address_space(3))) bf16x8*)(kp+6144); kf[7]=*(const __attribute__((address_space(3))) bf16x8*)(kp+6656);
}
__device__ __forceinline__ void kload2(bf16x8*kf,lds_cptr kp,int j){ kf[2*j]=*(const __attribute__((address_space(3))) bf16x8*)(kp+j*2048); kf[2*j+1]=*(const __attribute__((address_space(3))) bf16x8*)(kp+j*2048+512); }
__device__ __forceinline__ s16x4 vtr(lds_cptr p){ return __builtin_bit_cast(s16x4,__builtin_amdgcn_ds_read_tr16_b64_v4i16((__attribute__((address_space(3))) v4i16_t*)p)); }
__device__ __forceinline__ float rowmax(const f32x16&p0,const f32x16&p1){
  float a=max3f(p0[0],p0[1],p1[0]),b=max3f(p0[2],p0[3],p1[1]);a=max3f(a,p1[2],p1[3]);
  #pragma unroll
  for(int r=4;r<16;r+=4){a=max3f(a,p0[r],p0[r+1]);b=max3f(b,p0[r+2],p0[r+3]);a=max3f(a,p1[r],p1[r+1]);b=max3f(b,p1[r+2],p1[r+3]);}
  const float m=max2f(a,b);
  auto rr=__builtin_amdgcn_permlane32_swap(__float_as_uint(m),__float_as_uint(m),false,false);
  return max2f(__uint_as_float(rr[0]),__uint_as_float(rr[1]));
}
__device__ __forceinline__ void pv(f32x16*o,int vb,bf16x8 pa0,bf16x8 pa1,bf16x8 pa2,bf16x8 pa3){
  #pragma unroll
  for(int d0=0;d0<2;++d0){s16x4 lo[4],hi[4];
    #pragma unroll
    for(int ks=0;ks<4;++ks){
      asm volatile("ds_read_b64_tr_b16 %0,%1 offset:%c2":"=&v"(lo[ks]):"v"(vb),"i"(d0*4096+ks*1024):"memory");
      asm volatile("ds_read_b64_tr_b16 %0,%1 offset:%c2":"=&v"(hi[ks]):"v"(vb),"i"(d0*4096+ks*1024+512):"memory");}
    asm volatile("s_waitcnt lgkmcnt(0)":::"memory");SBAR();
    #define PK(k) (bf16x8){lo[k][0],lo[k][1],lo[k][2],lo[k][3],hi[k][0],hi[k][1],hi[k][2],hi[k][3]}
    o[d0]=__builtin_amdgcn_mfma_f32_32x32x16_bf16(pa0,PK(0),o[d0],0,0,0);
    o[d0]=__builtin_amdgcn_mfma_f32_32x32x16_bf16(pa1,PK(1),o[d0],0,0,0);
    o[d0]=__builtin_amdgcn_mfma_f32_32x32x16_bf16(pa2,PK(2),o[d0],0,0,0);
    o[d0]=__builtin_amdgcn_mfma_f32_32x32x16_bf16(pa3,PK(3),o[d0],0,0,0);
    #undef PK
  }
}

#ifndef ATTN_STORE16
#define ATTN_STORE16(p,v) (*(u32x4*)(p)=(v))
#endif
template<int THRL> __device__ __forceinline__ void attn_unit(const bf16*Qb,const bf16*__restrict__ Kh,const bf16*__restrict__ Vh,bf16*Ob,int opitch,int NT,char*shm){
  const int tid=opaque_tid(),lane=tid&63,r32=lane&31,hi=lane>>5; const int wid=__builtin_amdgcn_readfirstlane(tid>>6);
  const bf16*Qw=Qb+(long)(wid*QBLK)*DM;
  const unsigned lds0=(unsigned)(uintptr_t)shm;
  float*wsf=(float*)(shm+LDS_WS)+wid*64;
  const bf16*ksrc=Kh+(long)lane*DM+wid*8;
  const bf16*vsrc=Vh+(long)(16*(wid&3)+(lane>>2))*DM+(wid>>2)*32+(lane&3)*8;
  const unsigned kdst=lds0+LDS_K+wid*1024, vdst=lds0+LDS_V+wid*1024;
  #define DMA_K(t,slot) glds16(ksrc+(long)(t)*KVBLK*DM,(unsigned)__builtin_amdgcn_readfirstlane(kdst+(slot)))
  #define DMA_V(t,slot) glds16(vsrc+(long)(t)*KVBLK*DM,(unsigned)__builtin_amdgcn_readfirstlane(vdst+(slot)))
  const int vb0=(int)(lds0+LDS_V)+((lane>>4)&1)*32+(lane&3)*8+(4*hi+((lane&15)>>2))*64;
  const char*Kbase=shm+LDS_K; bf16x8 kf[8];
  const lds_cptr shm3=(lds_cptr)shm; const lds_cptr kp0=shm3+LDS_K+hi*1024+r32*16; const lds_cptr vp0=shm3+LDS_V+((lane>>4)&1)*32+(lane&3)*8+(4*hi+((lane&15)>>2))*64;
  DMA_K(0,0);DMA_V(0,0);DMA_K(1,SLOTB);
  bf16x8 qr[4];
  #pragma unroll
  for(int d0=0;d0<4;++d0)qr[d0]=*reinterpret_cast<const bf16x8*>(&Qw[(long)r32*DM+d0*16+hi*8]);
  float mhat=0.f,l_reg=0.f;f32x16 o[2];o[0]=f32x16{};o[1]=f32x16{};f32x16 negm=f32x16{};asm volatile("":"+v"(negm));
  #define CMASK(P0,P1,t) do{}while(0)
  bool resc=false;
  #define START(P0,P1) do{ const float rm=rowmax(P0,P1); resc=false; \
    { const float dl=rm; mhat=fadd_s(mhat,dl); \
      _Pragma("unroll") for(int r=0;r<16;++r){P0[r]=fsub_s(P0[r],dl);P1[r]=fsub_s(P1[r],dl);} \
      _Pragma("unroll") for(int r=0;r<16;++r)negm[r]=-mhat; asm volatile("":"+v"(negm)); } \
    _Pragma("unroll") for(int r=0;r<16;++r)P0[r]=__builtin_amdgcn_exp2f(P0[r]); }while(0)
  #define RESC() do{ if(resc){ asm volatile("s_waitcnt lgkmcnt(0)":::"memory"); \
      _Pragma("unroll") for(int d_=0;d_<2;++d_) _Pragma("unroll") for(int r=0;r<16;++r)o[d_][r]*=wsf[crow(r,hi)]; } }while(0)
  f32x16 pA0,pA1,pB0,pB1;
  int sl_prev=0,sl_cur=0,sl_next=SLOTB;
  #define ROT() do{sl_prev=sl_cur;sl_cur=sl_next;sl_next=(sl_next==(NSLOT-1)*SLOTB)?0:sl_next+SLOTB;}while(0)
  DMA_K(2,2*SLOTB);
  WAIT_BAR(3);
  qkt(pA0,pA1,Kbase,qr,negm,r32,hi);asm volatile("s_nop 15\n\ts_nop 7":"+v"(pA0),"+v"(pA1));CMASK(pA0,pA1,0);
  START(pA0,pA1);
  _Pragma("unroll") for(int r=0;r<16;++r)pA1[r]=__builtin_amdgcn_exp2f(pA1[r]);
  WAIT_BAR(0);
  DMA_K(3,0);DMA_V(1,SLOTB);
  ROT();
  kload8(kf,kp0+sl_cur);
  WAIT_BAR(2);
  s16x4 vlo[8],vhi[8]; u32x4 pw0,pw1,pw2,pw3;
  #define PKW(P,B) cvtpk_s(P[B],P[B+1])
  #define PAF(k) __builtin_bit_cast(bf16x8,pw##k)
  #define VFR(i) (bf16x8){vlo[i][0],vlo[i][1],vlo[i][2],vlo[i][3],vhi[i][0],vhi[i][1],vhi[i][2],vhi[i][3]}
  #define PIN(x) asm volatile("":"+v"(x))
  #define MX3(a,b,c) __builtin_fmaxf(__builtin_fmaxf((a),(b)),(c))
  #define GAPA(MF,A0,A1,A2,A3,W0,W1,PW) do{ MF; sacc+=A0; sacc+=A1; sacc+=A2; sacc+=A3; PIN(sacc); W0; W1; PIN(PW); SBAR(); }while(0)
  #define EX(v) __builtin_amdgcn_exp2f(v)
  #define GAPB(MF,X,B) do{ MF; X[B]=EX(X[B]); X[B+1]=EX(X[B+1]); X[B+2]=EX(X[B+2]); X[B+3]=EX(X[B+3]); PIN(X); SBAR(); }while(0)
  #define VRD(i) do{ vlo[i]=vtr(vp_+(((i)>>2)*4096+((i)&3)*1024)); vhi[i]=vtr(vp_+(((i)>>2)*4096+((i)&3)*1024+512)); }while(0)
  #define KRD(G,j) do{ if(G){ kload2(kf,kp0+sl_next,j); SBAR(); } }while(0)
  #define STEP(C0,C1,P0,P1,t,GK,GV,GL) do{ SBAR(); \
    const lds_cptr vp_=vp0+sl_prev; \
    VRD(0); SBAR(); float sacc=(P0[0]+P0[1]); \
    GAPA(C0=__builtin_amdgcn_mfma_f32_32x32x16_bf16(kf[0],qr[0],negm,0,0,0), P0[2],P0[3],P0[4],P0[5],     pw0[0]=PKW(P0,0), pw0[1]=PKW(P0,2), pw0); \
    VRD(4); SBAR(); GAPA(C1=__builtin_amdgcn_mfma_f32_32x32x16_bf16(kf[1],qr[0],negm,0,0,0), P0[6],P0[7],P0[8],P0[9],     pw0[2]=PKW(P0,4), pw0[3]=PKW(P0,6), pw0); \
    VRD(1); SBAR(); GAPA(C0=__builtin_amdgcn_mfma_f32_32x32x16_bf16(kf[2],qr[1],C0,0,0,0),   P0[10],P0[11],P0[12],P0[13], pw1[0]=PKW(P0,8), pw1[1]=PKW(P0,10), pw1); \
    VRD(5); SBAR(); GAPA(C1=__builtin_amdgcn_mfma_f32_32x32x16_bf16(kf[3],qr[1],C1,0,0,0),   P0[14],P0[15],P1[0],P1[1],   pw1[2]=PKW(P0,12),pw1[3]=PKW(P0,14), pw1); \
    VRD(2); SBAR(); GAPA(C0=__builtin_amdgcn_mfma_f32_32x32x16_bf16(kf[4],qr[2],C0,0,0,0),   P1[2],P1[3],P1[4],P1[5],     pw2[0]=PKW(P1,0), pw2[1]=PKW(P1,2), pw2); \
    VRD(6); SBAR(); GAPA(C1=__builtin_amdgcn_mfma_f32_32x32x16_bf16(kf[5],qr[2],C1,0,0,0),   P1[6],P1[7],P1[8],P1[9],     pw2[2]=PKW(P1,4), pw2[3]=PKW(P1,6), pw2); \
    VRD(3); SBAR(); GAPA(C0=__builtin_amdgcn_mfma_f32_32x32x16_bf16(kf[6],qr[3],C0,0,0,0),   P1[10],P1[11],P1[12],P1[13], pw3[0]=PKW(P1,8), pw3[1]=PKW(P1,10), pw3); \
    VRD(7); SBAR(); GAPA(C1=__builtin_amdgcn_mfma_f32_32x32x16_bf16(kf[7],qr[3],C1,0,0,0),   P1[14],P1[15],0.f,0.f,       pw3[2]=PKW(P1,12),pw3[3]=PKW(P1,14), pw3); \
    l_reg+=sacc; \
    if(GK){DMA_K((t)+3,sl_cur);} if(GV){DMA_V((t)+1,sl_next);} \
    CMASK(C0,C1,t); \
    { float a=MX3(C0[0],C0[1],C1[0]),b=MX3(C0[2],C0[3],C1[1]); a=MX3(a,C1[2],C1[3]); \
      _Pragma("unroll") for(int r=4;r<16;r+=4){a=MX3(a,C0[r],C0[r+1]);b=MX3(b,C0[r+2],C0[r+3]);a=MX3(a,C1[r],C1[r+1]);b=MX3(b,C1[r+2],C1[r+3]);} \
      float rm=__builtin_fmaxf(a,b); { auto rr=__builtin_amdgcn_permlane32_swap(__float_as_uint(rm),__float_as_uint(rm),false,false); rm=__builtin_fmaxf(__uint_as_float(rr[0]),__uint_as_float(rr[1])); } \
      resc=false; \
      if(__builtin_expect(__any(rm>(float)THRL),0)){ const float dl=__builtin_fmaxf(rm,0.f); mhat+=dl; \
        _Pragma("unroll") for(int r=0;r<16;++r){C0[r]-=dl;C1[r]-=dl;} \
        _Pragma("unroll") for(int r=0;r<16;++r)negm[r]=-mhat; asm volatile("":"+v"(negm)); \
        const float f=__builtin_amdgcn_exp2f(-dl); l_reg*=f; if(hi==0)wsf[r32]=f; resc=true; } } \
    SBAR(); \
    GAPB(o[0]=__builtin_amdgcn_mfma_f32_32x32x16_bf16(PAF(0),VFR(0),o[0],0,0,0), C0,0); \
    GAPB(o[1]=__builtin_amdgcn_mfma_f32_32x32x16_bf16(PAF(0),VFR(4),o[1],0,0,0), C0,4); \
    KRD(GL,0); GAPB(o[0]=__builtin_amdgcn_mfma_f32_32x32x16_bf16(PAF(1),VFR(1),o[0],0,0,0), C0,8); \
    KRD(GL,1); GAPB(o[1]=__builtin_amdgcn_mfma_f32_32x32x16_bf16(PAF(1),VFR(5),o[1],0,0,0), C0,12); \
    KRD(GL,2); GAPB(o[0]=__builtin_amdgcn_mfma_f32_32x32x16_bf16(PAF(2),VFR(2),o[0],0,0,0), C1,0); \
    KRD(GL,3); GAPB(o[1]=__builtin_amdgcn_mfma_f32_32x32x16_bf16(PAF(2),VFR(6),o[1],0,0,0), C1,4); \
    GAPB(o[0]=__builtin_amdgcn_mfma_f32_32x32x16_bf16(PAF(3),VFR(3),o[0],0,0,0), C1,8); \
    GAPB(o[1]=__builtin_amdgcn_mfma_f32_32x32x16_bf16(PAF(3),VFR(7),o[1],0,0,0), C1,12); \
    }while(0)
  if(wid>=4)__builtin_amdgcn_s_setprio(1);
  int t=1;
  #undef CMASK
  #define CMASK(P0,P1,t) do{}while(0)
  for(;t+5<NT;t+=2){
    STEP(pB0,pB1,pA0,pA1,t,true,true,true);     WAIT_BAR(2); RESC(); ROT();
    STEP(pA0,pA1,pB0,pB1,t+1,true,true,true);   WAIT_BAR(2); RESC(); ROT();
  }
  #undef CMASK
  #define CMASK(P0,P1,t) do{}while(0)
  #define ENDW(tt) do{ if((tt)+3<NT){WAIT_BAR(2);} else if((tt)+2<NT){WAIT_BAR(1);} else {WAIT_BAR(0);} }while(0)
  for(;t+1<NT;t+=2){
    STEP(pB0,pB1,pA0,pA1,t,(t+3<NT),(t+1<NT),(t+1<NT));       ENDW(t);   RESC(); ROT();
    STEP(pA0,pA1,pB0,pB1,t+1,(t+4<NT),(t+2<NT),(t+2<NT));     ENDW(t+1); RESC(); ROT();
  }
  STEP(pB0,pB1,pA0,pA1,NT-1,false,false,false); RESC();
  { float sacc=pB0[0]+pB0[1]; _Pragma("unroll") for(int r=2;r<16;++r)sacc+=pB0[r]; _Pragma("unroll") for(int r=0;r<16;++r)sacc+=pB1[r]; l_reg+=sacc;
    pw0=(u32x4){PKW(pB0,0),PKW(pB0,2),PKW(pB0,4),PKW(pB0,6)};pw1=(u32x4){PKW(pB0,8),PKW(pB0,10),PKW(pB0,12),PKW(pB0,14)};pw2=(u32x4){PKW(pB1,0),PKW(pB1,2),PKW(pB1,4),PKW(pB1,6)};pw3=(u32x4){PKW(pB1,8),PKW(pB1,10),PKW(pB1,12),PKW(pB1,14)};
    SBAR(); pv(o,vb0+sl_cur,PAF(0),PAF(1),PAF(2),PAF(3)); }
  #undef PKW
  #undef PAF
  #undef VFR
  #undef PIN
  #undef MX3
  #undef GAPA
  #undef GAPB
  #undef EX
  #undef VRD
  #undef KRD
  #undef STEP
  #undef ENDW
  __builtin_amdgcn_s_setprio(0);
  {auto rr=__builtin_amdgcn_permlane32_swap(__float_as_uint(l_reg),__float_as_uint(l_reg),false,false);l_reg=__uint_as_float(rr[0])+__uint_as_float(rr[1]);}
  if(hi==0)wsf[32+r32]=l_reg;asm volatile("s_waitcnt lgkmcnt(0)":::"memory");
  float rli[16];
  #pragma unroll
  for(int r=0;r<16;++r)rli[r]=__builtin_amdgcn_rcpf(wsf[32+crow(r,hi)]);
  bf16*Ow=Ob+(long)(wid*QBLK)*opitch;
  { bf16*stg=(bf16*)(shm+LDS_OST)+wid*2048;
    #pragma unroll
    for(int r=0;r<16;++r){const int orow=crow(r,hi);
      #pragma unroll
      for(int d0=0;d0<2;++d0)stg[orow*64+d0*32+r32]=__float2bfloat16(o[d0][r]*rli[r]);}
    asm volatile("s_waitcnt lgkmcnt(0)":::"memory");
    #pragma unroll
    for(int i=0;i<4;++i){const int row=i*8+(lane>>3),ch=lane&7; const u32x4 v=*(const u32x4*)(stg+row*64+ch*8); ATTN_STORE16(Ow+(long)row*opitch+ch*8,v);} }
  asm volatile("s_waitcnt lgkmcnt(0)\n\ts_barrier":::"memory");
  #undef DMA_K
  #undef DMA_V
  #undef CMASK
  #undef START
  #undef RESC
  #undef ROT
}
__device__ __forceinline__ void pv128(f32x16*o,int vb,bf16x8 pa0,bf16x8 pa1,bf16x8 pa2,bf16x8 pa3){
  #pragma unroll
  for(int d0=0;d0<4;++d0){s16x4 lo[4],hi[4];
    #pragma unroll
    for(int ks=0;ks<4;++ks){
      asm volatile("ds_read_b64_tr_b16 %0,%1 offset:%c2":"=&v"(lo[ks]):"v"(vb),"i"(d0*4096+ks*1024):"memory");
      asm volatile("ds_read_b64_tr_b16 %0,%1 offset:%c2":"=&v"(hi[ks]):"v"(vb),"i"(d0*4096+ks*1024+512):"memory");}
    asm volatile("s_waitcnt lgkmcnt(0)":::"memory");SBAR();
    #define PK(k) (bf16x8){lo[k][0],lo[k][1],lo[k][2],lo[k][3],hi[k][0],hi[k][1],hi[k][2],hi[k][3]}
    o[d0]=__builtin_amdgcn_mfma_f32_32x32x16_bf16(pa0,PK(0),o[d0],0,0,0);
    o[d0]=__builtin_amdgcn_mfma_f32_32x32x16_bf16(pa1,PK(1),o[d0],0,0,0);
    o[d0]=__builtin_amdgcn_mfma_f32_32x32x16_bf16(pa2,PK(2),o[d0],0,0,0);
    o[d0]=__builtin_amdgcn_mfma_f32_32x32x16_bf16(pa3,PK(3),o[d0],0,0,0);
    #undef PK
  }
}
constexpr int LDS_WS128=LDS_V+NSLOT*16384, LDS_OST128=LDS_WS128+NW*64*4, LDS_BYTES128=LDS_OST128+NW*8192;
template<int THRL> __device__ __forceinline__ void attn_unit128(const bf16*Qb,const bf16*__restrict__ Kh,const bf16*__restrict__ Vh,bf16*Ob,int opitch,int NT,char*shm){
  const int tid=opaque_tid(),lane=tid&63,r32=lane&31,hi=lane>>5; const int wid=__builtin_amdgcn_readfirstlane(tid>>6);
  const bf16*Qw=Qb+(long)(wid*QBLK)*DM;
  const unsigned lds0=(unsigned)(uintptr_t)shm;
  float*wsf=(float*)(shm+LDS_WS128)+wid*64;
  const bf16*ksrc=Kh+(long)lane*DM+wid*8;
  const bf16*vsrc=Vh+(long)(16*(wid&3)+(lane>>2))*DM+(wid>>2)*32+(lane&3)*8;
  const unsigned kdst=lds0+LDS_K+wid*1024, vdst=lds0+LDS_V+wid*1024;
  #define DMA_K(t,slot) glds16(ksrc+(long)(t)*KVBLK*DM,(unsigned)__builtin_amdgcn_readfirstlane(kdst+(slot)))
  #define DMA_V(t,slot) do{ glds16(vsrc+(long)(t)*KVBLK*DM,(unsigned)__builtin_amdgcn_readfirstlane(vdst+2*(slot))); glds16(vsrc+64+(long)(t)*KVBLK*DM,(unsigned)__builtin_amdgcn_readfirstlane(vdst+2*(slot)+8192)); }while(0)
  const int vb0=(int)(lds0+LDS_V)+((lane>>4)&1)*32+(lane&3)*8+(4*hi+((lane&15)>>2))*64;
  const char*Kbase=shm+LDS_K; bf16x8 kf[8];
  const lds_cptr shm3=(lds_cptr)shm; const lds_cptr kp0=shm3+LDS_K+hi*1024+r32*16; const lds_cptr vp0=shm3+LDS_V+((lane>>4)&1)*32+(lane&3)*8+(4*hi+((lane&15)>>2))*64;
  DMA_K(0,0);DMA_V(0,0);DMA_K(1,SLOTB);
  bf16x8 qr[4];
  #pragma unroll
  for(int d0=0;d0<4;++d0)qr[d0]=*reinterpret_cast<const bf16x8*>(&Qw[(long)r32*DM+d0*16+hi*8]);
  float mhat=0.f,l_reg=0.f;f32x16 o[4];o[0]=f32x16{};o[1]=f32x16{};o[2]=f32x16{};o[3]=f32x16{};float negmf=0.f; const f32x16 zero16=f32x16{};
  #define CMASK(P0,P1,t) do{}while(0)
  bool resc=false;
  #define START(P0,P1) do{ const float rm=rowmax(P0,P1); resc=false; \
    { const float dl=rm; mhat=fadd_s(mhat,dl); \
      _Pragma("unroll") for(int r=0;r<16;++r){P0[r]=fsub_s(P0[r],dl);P1[r]=fsub_s(P1[r],dl);} \
      negmf=-mhat; } \
    _Pragma("unroll") for(int r=0;r<16;++r)P0[r]=__builtin_amdgcn_exp2f(P0[r]); }while(0)
  #define RESC() do{ if(resc){ asm volatile("s_waitcnt lgkmcnt(0)":::"memory"); \
      _Pragma("unroll") for(int d_=0;d_<4;++d_) _Pragma("unroll") for(int r=0;r<16;++r)o[d_][r]*=wsf[crow(r,hi)]; } }while(0)
  f32x16 pA0,pA1,pB0,pB1;
  int sl_prev=0,sl_cur=0,sl_next=SLOTB;
  #define ROT() do{sl_prev=sl_cur;sl_cur=sl_next;sl_next=(sl_next==(NSLOT-1)*SLOTB)?0:sl_next+SLOTB;}while(0)
  DMA_K(2,2*SLOTB);
  WAIT_BAR(3);
  qkt(pA0,pA1,Kbase,qr,zero16,r32,hi);asm volatile("s_nop 15\n\ts_nop 7":"+v"(pA0),"+v"(pA1));CMASK(pA0,pA1,0);
  START(pA0,pA1);
  _Pragma("unroll") for(int r=0;r<16;++r)pA1[r]=__builtin_amdgcn_exp2f(pA1[r]);
  WAIT_BAR(0);
  DMA_K(3,0);DMA_V(1,SLOTB);
  ROT();
  kload8(kf,kp0+sl_cur);
  WAIT_BAR(3);
  s16x4 vlo[4],vhi[4]; u32x4 pw0,pw1,pw2,pw3;
  #define PKW(P,B) cvtpk_s(P[B],P[B+1])
  #define PAF(k) __builtin_bit_cast(bf16x8,pw##k)
  #define VFR(i) (bf16x8){vlo[i][0],vlo[i][1],vlo[i][2],vlo[i][3],vhi[i][0],vhi[i][1],vhi[i][2],vhi[i][3]}
  #define PIN(x) asm volatile("":"+v"(x))
  #define MX3(a,b,c) __builtin_fmaxf(__builtin_fmaxf((a),(b)),(c))
  #define GAPA(MF,A0,A1,A2,A3,W0,W1,PW) do{ MF; sacc+=A0; sacc+=A1; sacc+=A2; sacc+=A3; PIN(sacc); W0; W1; PIN(PW); SBAR(); }while(0)
  #define EX(v) __builtin_amdgcn_exp2f(v)
  #define GAPB(MF,X,B) do{ MF; X[B]=EX(X[B]); X[B+1]=EX(X[B+1]); X[B+2]=EX(X[B+2]); X[B+3]=EX(X[B+3]); PIN(X); SBAR(); }while(0)
  #define GAPB2(MF,X,B) do{ MF; X[B]=EX(X[B]); X[B+1]=EX(X[B+1]); PIN(X); SBAR(); }while(0)
  #define VRDX(reg,fr) do{ vlo[reg]=vtr(vp_+(((fr)>>2)*4096+((fr)&3)*1024)); vhi[reg]=vtr(vp_+(((fr)>>2)*4096+((fr)&3)*1024+512)); }while(0)
  #define VRD(i) do{ vlo[i]=vtr(vp_+(((i)>>2)*4096+((i)&3)*1024)); vhi[i]=vtr(vp_+(((i)>>2)*4096+((i)&3)*1024+512)); }while(0)
  #define KRD(G,j) do{ if(G){ kload2(kf,kp0+sl_next,j); SBAR(); } }while(0)
  #define STEP(C0,C1,P0,P1,t,GK,GV,GL) do{ SBAR(); \
    const lds_cptr vp_=vp0+2*sl_prev; \
    VRDX(0,0); SBAR(); float sacc=(P0[0]+P0[1]); \
    GAPA(C0=__builtin_amdgcn_mfma_f32_32x32x16_bf16(kf[0],qr[0],zero16,0,0,0), P0[2],P0[3],P0[4],P0[5],     pw0[0]=PKW(P0,0), pw0[1]=PKW(P0,2), pw0); \
    VRDX(1,4); SBAR(); GAPA(C1=__builtin_amdgcn_mfma_f32_32x32x16_bf16(kf[1],qr[0],zero16,0,0,0), P0[6],P0[7],P0[8],P0[9],     pw0[2]=PKW(P0,4), pw0[3]=PKW(P0,6), pw0); \
    VRDX(2,1); SBAR(); GAPA(C0=__builtin_amdgcn_mfma_f32_32x32x16_bf16(kf[2],qr[1],C0,0,0,0),   P0[10],P0[11],P0[12],P0[13], pw1[0]=PKW(P0,8), pw1[1]=PKW(P0,10), pw1); \
    VRDX(3,5); SBAR(); GAPA(C1=__builtin_amdgcn_mfma_f32_32x32x16_bf16(kf[3],qr[1],C1,0,0,0),   P0[14],P0[15],P1[0],P1[1],   pw1[2]=PKW(P0,12),pw1[3]=PKW(P0,14), pw1); \
    GAPA(C0=__builtin_amdgcn_mfma_f32_32x32x16_bf16(kf[4],qr[2],C0,0,0,0),   P1[2],P1[3],P1[4],P1[5],     pw2[0]=PKW(P1,0), pw2[1]=PKW(P1,2), pw2); \
    GAPA(C1=__builtin_amdgcn_mfma_f32_32x32x16_bf16(kf[5],qr[2],C1,0,0,0),   P1[6],P1[7],P1[8],P1[9],     pw2[2]=PKW(P1,4), pw2[3]=PKW(P1,6), pw2); \
    GAPA(C0=__builtin_amdgcn_mfma_f32_32x32x16_bf16(kf[6],qr[3],C0,0,0,0),   P1[10],P1[11],P1[12],P1[13], pw3[0]=PKW(P1,8), pw3[1]=PKW(P1,10), pw3); \
    GAPA(C1=__builtin_amdgcn_mfma_f32_32x32x16_bf16(kf[7],qr[3],C1,0,0,0),   P1[14],P1[15],0.f,0.f,       pw3[2]=PKW(P1,12),pw3[3]=PKW(P1,14), pw3); \
    l_reg+=sacc; \
    if(GK){DMA_K((t)+3,sl_cur);} if(GV){DMA_V((t)+1,sl_next);} \
    _Pragma("unroll") for(int r=0;r<16;++r){C0[r]+=negmf;C1[r]+=negmf;} \
    { float a=MX3(C0[0],C0[1],C1[0]),b=MX3(C0[2],C0[3],C1[1]); a=MX3(a,C1[2],C1[3]); \
      _Pragma("unroll") for(int r=4;r<16;r+=4){a=MX3(a,C0[r],C0[r+1]);b=MX3(b,C0[r+2],C0[r+3]);a=MX3(a,C1[r],C1[r+1]);b=MX3(b,C1[r+2],C1[r+3]);} \
      float rm=__builtin_fmaxf(a,b); { auto rr=__builtin_amdgcn_permlane32_swap(__float_as_uint(rm),__float_as_uint(rm),false,false); rm=__builtin_fmaxf(__uint_as_float(rr[0]),__uint_as_float(rr[1])); } \
      resc=false; \
      if(__builtin_expect(__any(rm>(float)THRL),0)){ const float dl=__builtin_fmaxf(rm,0.f); mhat+=dl; \
        _Pragma("unroll") for(int r=0;r<16;++r){C0[r]-=dl;C1[r]-=dl;} \
        negmf=-mhat; \
        const float f=__builtin_amdgcn_exp2f(-dl); l_reg*=f; if(hi==0)wsf[r32]=f; resc=true; } } \
    SBAR(); \
    GAPB2(o[0]=__builtin_amdgcn_mfma_f32_32x32x16_bf16(PAF(0),VFR(0),o[0],0,0,0), C0,0); VRDX(0,2); SBAR(); \
    GAPB2(o[1]=__builtin_amdgcn_mfma_f32_32x32x16_bf16(PAF(0),VFR(1),o[1],0,0,0), C0,2); VRDX(1,6); SBAR(); \
    KRD(GL,0); GAPB2(o[0]=__builtin_amdgcn_mfma_f32_32x32x16_bf16(PAF(1),VFR(2),o[0],0,0,0), C0,4); VRDX(2,3); SBAR(); \
    KRD(GL,1); GAPB2(o[1]=__builtin_amdgcn_mfma_f32_32x32x16_bf16(PAF(1),VFR(3),o[1],0,0,0), C0,6); VRDX(3,7); SBAR(); \
    KRD(GL,2); GAPB2(o[0]=__builtin_amdgcn_mfma_f32_32x32x16_bf16(PAF(2),VFR(0),o[0],0,0,0), C0,8); VRDX(0,8); SBAR(); \
    KRD(GL,3); GAPB2(o[1]=__builtin_amdgcn_mfma_f32_32x32x16_bf16(PAF(2),VFR(1),o[1],0,0,0), C0,10); VRDX(1,12); SBAR(); \
    GAPB2(o[0]=__builtin_amdgcn_mfma_f32_32x32x16_bf16(PAF(3),VFR(2),o[0],0,0,0), C0,12); VRDX(2,9); SBAR(); \
    GAPB2(o[1]=__builtin_amdgcn_mfma_f32_32x32x16_bf16(PAF(3),VFR(3),o[1],0,0,0), C0,14); VRDX(3,13); SBAR(); \
    GAPB2(o[2]=__builtin_amdgcn_mfma_f32_32x32x16_bf16(PAF(0),VFR(0),o[2],0,0,0), C1,0); VRDX(0,10); SBAR(); \
    GAPB2(o[3]=__builtin_amdgcn_mfma_f32_32x32x16_bf16(PAF(0),VFR(1),o[3],0,0,0), C1,2); VRDX(1,14); SBAR(); \
    GAPB2(o[2]=__builtin_amdgcn_mfma_f32_32x32x16_bf16(PAF(1),VFR(2),o[2],0,0,0), C1,4); VRDX(2,11); SBAR(); \
    GAPB2(o[3]=__builtin_amdgcn_mfma_f32_32x32x16_bf16(PAF(1),VFR(3),o[3],0,0,0), C1,6); VRDX(3,15); SBAR(); \
    GAPB2(o[2]=__builtin_amdgcn_mfma_f32_32x32x16_bf16(PAF(2),VFR(0),o[2],0,0,0), C1,8); \
    GAPB2(o[3]=__builtin_amdgcn_mfma_f32_32x32x16_bf16(PAF(2),VFR(1),o[3],0,0,0), C1,10); \
    GAPB2(o[2]=__builtin_amdgcn_mfma_f32_32x32x16_bf16(PAF(3),VFR(2),o[2],0,0,0), C1,12); \
    GAPB2(o[3]=__builtin_amdgcn_mfma_f32_32x32x16_bf16(PAF(3),VFR(3),o[3],0,0,0), C1,14); \
    }while(0)
  if(wid>=4)__builtin_amdgcn_s_setprio(1);
  int t=1;
  #undef CMASK
  #define CMASK(P0,P1,t) do{}while(0)
  for(;t+5<NT;t+=2){
    STEP(pB0,pB1,pA0,pA1,t,true,true,true);     WAIT_BAR(3); RESC(); ROT();
    STEP(pA0,pA1,pB0,pB1,t+1,true,true,true);   WAIT_BAR(3); RESC(); ROT();
  }
  #undef CMASK
  #define CMASK(P0,P1,t) do{}while(0)
  #define ENDW(tt) do{ if((tt)+3<NT){WAIT_BAR(3);} else if((tt)+2<NT){WAIT_BAR(2);} else {WAIT_BAR(0);} }while(0)
  for(;t+1<NT;t+=2){
    STEP(pB0,pB1,pA0,pA1,t,(t+3<NT),(t+1<NT),(t+1<NT));       ENDW(t);   RESC(); ROT();
    STEP(pA0,pA1,pB0,pB1,t+1,(t+4<NT),(t+2<NT),(t+2<NT));     ENDW(t+1); RESC(); ROT();
  }
  STEP(pB0,pB1,pA0,pA1,NT-1,false,false,false); RESC();
  { float sacc=pB0[0]+pB0[1]; _Pragma("unroll") for(int r=2;r<16;++r)sacc+=pB0[r]; _Pragma("unroll") for(int r=0;r<16;++r)sacc+=pB1[r]; l_reg+=sacc;
    pw0=(u32x4){PKW(pB0,0),PKW(pB0,2),PKW(pB0,4),PKW(pB0,6)};pw1=(u32x4){PKW(pB0,8),PKW(pB0,10),PKW(pB0,12),PKW(pB0,14)};pw2=(u32x4){PKW(pB1,0),PKW(pB1,2),PKW(pB1,4),PKW(pB1,6)};pw3=(u32x4){PKW(pB1,8),PKW(pB1,10),PKW(pB1,12),PKW(pB1,14)};
    SBAR(); pv128(o,vb0+2*sl_cur,PAF(0),PAF(1),PAF(2),PAF(3)); }
  #undef PKW
  #undef PAF
  #undef VFR
  #undef PIN
  #undef MX3
  #undef GAPA
  #undef GAPB
  #undef EX
  #undef VRD
  #undef VRDX
  #undef GAPB2
  #undef KRD
  #undef STEP
  #undef ENDW
  __builtin_amdgcn_s_setprio(0);
  {auto rr=__builtin_amdgcn_permlane32_swap(__float_as_uint(l_reg),__float_as_uint(l_reg),false,false);l_reg=__uint_as_float(rr[0])+__uint_as_float(rr[1]);}
  if(hi==0)wsf[32+r32]=l_reg;asm volatile("s_waitcnt lgkmcnt(0)":::"memory");
  float rli[16];
  #pragma unroll
  for(int r=0;r<16;++r)rli[r]=__builtin_amdgcn_rcpf(wsf[32+crow(r,hi)]);
  bf16*Ow=Ob+(long)(wid*QBLK)*opitch;
  { bf16*stg=(bf16*)(shm+LDS_OST128)+wid*4096;
    #pragma unroll
    for(int r=0;r<16;++r){const int orow=crow(r,hi);
      #pragma unroll
      for(int d0=0;d0<4;++d0)stg[orow*128+d0*32+r32]=__float2bfloat16(o[d0][r]*rli[r]);}
    asm volatile("s_waitcnt lgkmcnt(0)":::"memory");
    #pragma unroll
    for(int i=0;i<8;++i){const int row=i*4+(lane>>4),ch=lane&15; const u32x4 v=*(const u32x4*)(stg+row*128+ch*8); ATTN_STORE16(Ow+(long)row*opitch+ch*8,v);} }
  asm volatile("s_waitcnt lgkmcnt(0)\n\ts_barrier":::"memory");
  #undef DMA_K
  #undef DMA_V
  #undef CMASK
  #undef START
  #undef RESC
  #undef ROT
}
constexpr int ATTN_LDS_BYTES=LDS_BYTES128;
#undef SBAR
#undef WAIT_BAR
}
__device__ __forceinline__ int prow_std(int c) { const int t = c & 255; return (c & ~255) + ((t >> 5) & 1) * 128 + (t >> 6) * 32 + ((t >> 2) & 1) * 16 + ((t >> 3) & 3) * 4 + (t & 3); }
__device__ __forceinline__ int prow_gu(int f, int isup) { const int c = f & 127; return (f >> 7) * 256 + isup * 128 + (c >> 5) * 32 + ((c >> 2) & 1) * 16 + ((c >> 3) & 3) * 4 + (c & 3); }

struct TrDesc { const float* src; bf16_t* dst; int ldw, ldt, nl0, mode, nper; };
__device__ __forceinline__ void tr_load(const TrDesc& d, f32x4 (&a)[8], f32x4 (&b)[8], int lane) {
    const int nc = lane & 15, kr = lane >> 4;
#pragma unroll
    for (int it = 0; it < 8; ++it) { const int kp = kr + 4 * it;
        a[it] = __builtin_nontemporal_load((const f32x4*)(d.src + (size_t)(2 * kp) * d.ldw + 4 * nc)); b[it] = __builtin_nontemporal_load((const f32x4*)(d.src + (size_t)(2 * kp + 1) * d.ldw + 4 * nc)); }
}
__device__ __forceinline__ void tr_process(const TrDesc& d, const f32x4 (&a)[8], const f32x4 (&b)[8], LAS unsigned* scr, int lane) {
    const int nc = lane & 15, kr = lane >> 4;
#pragma unroll
    for (int it = 0; it < 8; ++it) { const int kp = kr + 4 * it;
#pragma unroll
        for (int i = 0; i < 4; ++i) scr[(4 * nc + i) * 66 + kp] = cvtpk(a[it][i], b[it][i]); }
    LDS_WAIT();
#pragma unroll
    for (int it = 0; it < 8; ++it) {
        const int n = (lane >> 3) + 8 * it, c = lane & 7;
        const LAS u32x2* s = (const LAS u32x2*)(scr + n * 66 + 4 * c);
        const u32x2 lo = s[0], hi = s[1];
        const int cl = d.nl0 + n;
        const int pr = (d.mode == 0) ? prow_std(cl) : prow_gu(cl, d.mode - 1);
        *(u32x4*)(d.dst + (size_t)pr * d.ldt + 8 * c) = (u32x4){lo.x, lo.y, hi.x, hi.y};
    }
    LDS_WAIT();
}
#define GAS __attribute__((address_space(1)))
struct TrLane { const GAS float* s; GAS bf16_t* t; int ldw, ldt, nb, nper, mode; };
__device__ __forceinline__ TrLane tr_lane(const TrDesc& d, int lane) {
    TrLane L; const bool f8 = d.mode != 0;
    L.s = (const GAS float*)d.src - d.nl0 + (size_t)((f8 ? 4 : 2) * (lane >> 4)) * d.ldw + 4 * (lane & 15);
    L.t = f8 ? (GAS bf16_t*)((GAS unsigned char*)d.dst + 16 * (lane & 3)) : (GAS bf16_t*)d.dst + 8 * (lane & 7); L.ldw = d.ldw; L.ldt = d.ldt; L.nb = d.nl0 >> 6;
    L.nper = d.nper; L.mode = d.mode;
    asm volatile("" : "+v"(L.s), "+v"(L.t), "+v"(L.ldw), "+v"(L.ldt), "+v"(L.nb), "+v"(L.nper), "+v"(L.mode));
    return L;
}
__device__ __forceinline__ void tr_adv(TrLane& L) { const bool w = (L.nb + 1 == L.nper); L.nb = w ? 0 : L.nb + 1; L.s += w ? (size_t)64 * L.ldw : (size_t)0; L.t += w ? ((L.mode != 0) ? 32 : 64) : 0; }
__device__ __forceinline__ void tr_load_l(const TrLane& L, f32x4 (&a)[8], f32x4 (&b)[8]) {
    const int sc = L.nb * 64;
    const bool f8 = L.mode != 0;
#pragma unroll
    for (int it = 0; it < 8; ++it) { const int ro = f8 ? 16 * (it >> 1) + 2 * (it & 1) : 8 * it; const GAS float* r = L.s + (size_t)ro * L.ldw + sc;
        a[it] = __builtin_nontemporal_load((const GAS f32x4*)r); b[it] = __builtin_nontemporal_load((const GAS f32x4*)(r + L.ldw)); }
}
__device__ __forceinline__ void tr_process_l(const TrLane& L, const f32x4 (&a)[8], const f32x4 (&b)[8], LAS unsigned* scr, int lane) {
    const int nc = lane & 15, kr = lane >> 4;
    if (L.mode != 0) {
#pragma unroll
        for (int t = 0; t < 4; ++t)
#pragma unroll
            for (int i = 0; i < 4; ++i) scr[(4 * nc + i) * 20 + kr + 4 * t] = cvt4_fp8_nc(a[2 * t][i] * F8_WSCALE, b[2 * t][i] * F8_WSCALE, a[2 * t + 1][i] * F8_WSCALE, b[2 * t + 1][i] * F8_WSCALE);
        LDS_WAIT();
#pragma unroll
        for (int it = 0; it < 4; ++it) {
            const int n = (lane >> 2) + 16 * it, c4 = lane & 3;
            const u32x4 v = *(const LAS u32x4*)(scr + n * 20 + 4 * c4);
            const int cl = L.nb * 64 + n;
            const int pr = (L.mode == 3) ? prow_std(cl) : prow_gu(cl, L.mode - 1);
            *(GAS u32x4*)((GAS unsigned char*)L.t + (size_t)pr * L.ldt) = v;
        }
        LDS_WAIT();
        return;
    }
#pragma unroll
    for (int it = 0; it < 8; ++it) { const int kp = kr + 4 * it;
#pragma unroll
        for (int i = 0; i < 4; ++i) scr[(4 * nc + i) * 66 + kp] = cvtpk(a[it][i], b[it][i]); }
    LDS_WAIT();
#pragma unroll
    for (int it = 0; it < 8; ++it) {
        const int n = (lane >> 3) + 8 * it, c = lane & 7;
        const LAS u32x2* sp = (const LAS u32x2*)(scr + n * 66 + 4 * c);
        const u32x2 lo = sp[0], hi = sp[1];
        const int cl = L.nb * 64 + n;
        *(GAS u32x4*)(L.t + (size_t)prow_std(cl) * L.ldt) = (u32x4){lo.x, lo.y, hi.x, hi.y};
    }
    LDS_WAIT();
}
constexpr int TR_I_INB = 16 * 68, TR_I_GT = 16 * 48, TR_I_IN = TR_I_INB + TR_I_GT, TR_I_BR = 8 * 16, TR_I_OUT = 16 * 16, TR_I_G = 16 * 32, TR_I_D = 32 * 16;
constexpr int TR_I_NONEXP = TR_I_IN + 3 * TR_I_BR + TR_I_OUT;
constexpr int TR_I_EXP = 2 * TR_I_G + TR_I_D;
constexpr int TR_PRO_ITEMS = TR_I_NONEXP;
constexpr int TR_BG_L0GU = NE * 2 * TR_I_G;
constexpr int TR_BG_L0 = NE * TR_I_EXP;
constexpr int TR_BG_ITEMS = 2 * NE * TR_I_EXP;
__device__ __forceinline__ TrDesc tr_decode_dense(const Params& p, int l, int r) {
    unsigned char* ws = p.ws; TrDesc d;
    if (r < TR_I_INB) { const int kb = r / 68, nb = r % 68, nl0 = nb * 64;
        d.src = p.w_in + (size_t)l * 1024 * INCOLS + (size_t)kb * 64 * INCOLS + nl0; d.ldw = INCOLS; d.dst = (bf16_t*)(ws + WS_WIN) + (size_t)l * NPROJ * 1024 + kb * 64; d.ldt = 1024; d.nl0 = nl0; d.mode = 0; d.nper = 68; return d; }
    r -= TR_I_INB;
    if (r < TR_I_GT) { const int kb = r / 48, nb = r % 48, nl0 = nb * 64;
        d.src = p.w_in + (size_t)l * 1024 * INCOLS + (size_t)kb * 64 * INCOLS + 4368 + nl0; d.ldw = INCOLS; d.dst = (bf16_t*)(ws + WS_WG8 + (size_t)l * 3072 * 1024 + kb * 64); d.ldt = 1024; d.nl0 = nl0; d.mode = 3; d.nper = 48; return d; }
    r -= TR_I_GT;
    if (r < 3 * TR_I_BR) { const int br = r / TR_I_BR, q = r % TR_I_BR, kb = q / 16, nb = q % 16; const float* W = (br == 0 ? p.wbr_a : br == 1 ? p.wbr_b : p.wbr_c) + (size_t)l * 512 * 1024;
        d.src = W + (size_t)kb * 64 * 1024 + nb * 64; d.ldw = 1024; d.dst = (bf16_t*)(ws + WS_WBR) + (size_t)l * 1024 * 1536 + br * 512 + kb * 64; d.ldt = 1536; d.nl0 = nb * 64; d.mode = 0; d.nper = 16; return d; }
    r -= 3 * TR_I_BR;
    { const int kb = r / 16, nb = r % 16;
        d.src = p.w_out + (size_t)l * 1024 * 1024 + (size_t)kb * 64 * 1024 + nb * 64; d.ldw = 1024; d.dst = (bf16_t*)(ws + WS_WOUT) + (size_t)l * 1024 * 1024 + kb * 64; d.ldt = 1024; d.nl0 = nb * 64; d.mode = 0; d.nper = 16; return d; }
}
__device__ __forceinline__ TrDesc tr_decode_expert(const Params& p, int l, int e, int r) {
    unsigned char* ws = p.ws; TrDesc d; const size_t le = (size_t)l * NE + e;
    if (r < 2 * TR_I_G) { const int up = r >= TR_I_G; r -= up * TR_I_G; const int kb = r / 32, nb = r % 32;
        d.src = (up ? p.wu : p.wg) + le * 1024 * 2048 + (size_t)kb * 64 * 2048 + nb * 64; d.ldw = 2048; d.dst = (bf16_t*)(ws + WS_WGU + le * 4096 * 1024 + kb * 64); d.ldt = 1024; d.nl0 = nb * 64; d.mode = 1 + up; d.nper = 32; return d; }
    r -= 2 * TR_I_G;
    { const int kb = r / 16, nb = r % 16;
        d.src = p.wd + le * 2048 * 1024 + (size_t)kb * 64 * 1024 + nb * 64; d.ldw = 1024; d.dst = (bf16_t*)(ws + WS_WDN + le * 1024 * 2048 + kb * 64); d.ldt = 2048; d.nl0 = nb * 64; d.mode = 3; d.nper = 16; return d; }
}
__device__ __forceinline__ TrDesc tr_decode_pro(const Params& p, int it) { return tr_decode_dense(p, it / TR_I_NONEXP, it % TR_I_NONEXP); }
__device__ __forceinline__ TrDesc tr_decode_bg(const Params& p, int q) {
    if (q < TR_BG_L0GU) return tr_decode_expert(p, 0, q / (2 * TR_I_G), q % (2 * TR_I_G));
    if (q < TR_BG_L0) { q -= TR_BG_L0GU; return tr_decode_expert(p, 0, q / TR_I_D, 2 * TR_I_G + q % TR_I_D); }
    if (q < TR_BG_ITEMS) { q -= TR_BG_L0; return tr_decode_expert(p, 1, q / TR_I_EXP, q % TR_I_EXP); }
    q -= TR_BG_ITEMS; return tr_decode_dense(p, 1, q < TR_I_NONEXP ? q : TR_I_NONEXP - 1);
}
__device__ __forceinline__ void convert_item(const Params& p, LAS unsigned char* lds, int e0) {
    const int tid = opaque_tid(), lane = tid & 63, wid = __builtin_amdgcn_readfirstlane(tid >> 6);
    LAS unsigned* scr = (LAS unsigned*)lds + wid * (64 * 66);
    const int q0 = e0 + wid * 32;
    if (q0 < TR_BG_ITEMS + TR_I_NONEXP) {
        TrLane LA = tr_lane(tr_decode_bg(p, q0), lane), LB = LA; tr_adv(LB);
        f32x4 a[8], b[8], a2[8], b2[8]; tr_load_l(LA, a, b);
#pragma unroll 1
        for (int k = 0; k < 32; k += 2) {
            tr_load_l(LB, a2, b2);
            tr_process_l(LA, a, b, scr, lane);
            LA = LB; if (k + 2 < 32) tr_adv(LA);
            tr_load_l(LA, a, b);
            tr_process_l(LB, a2, b2, scr, lane);
            LB = LA; tr_adv(LB);
        }
        asm volatile("" :: "v"(a[0]), "v"(a[1]), "v"(a[2]), "v"(a[3]), "v"(a[4]), "v"(a[5]), "v"(a[6]), "v"(a[7]), "v"(b[0]), "v"(b[1]), "v"(b[2]), "v"(b[3]), "v"(b[4]), "v"(b[5]), "v"(b[6]), "v"(b[7]));
    }
    __syncthreads();
}

__device__ __forceinline__ void prologue(const Params& p, LAS unsigned char* lds) {
    const int tid = opaque_tid(), lane = tid & 63, wid = __builtin_amdgcn_readfirstlane(tid >> 6), G = gridDim.x;
    unsigned char* ws = p.ws;
    { float* cosT = (float*)(ws + WS_ROPE); float* sinT = cosT + LAT * 32;
      for (int idx = blockIdx.x * NTHREADS + tid; idx < LAT * 32; idx += G * NTHREADS) {
          const int t = idx >> 5, i = idx & 31; const float pos = (float)((i < 16) ? (t / GRIDW) : (t % GRIDW));
          const float inv = powf(10000.0f, -(float)(i & 15) / 16.0f); const float ang = pos * inv;
          cosT[idx] = cosf(ang); sinT[idx] = sinf(ang); } }
    if (blockIdx.x < 192) {
        float* MOD = (float*)(ws + WS_MOD); LAS float* sl = (LAS float*)lds; LAS float* red = sl + 9 * 1024;
        for (int o = tid; o < 9 * 1024; o += NTHREADS) { const int m = o >> 10, k = o & 1023; const float cv = (m < 8) ? p.c[m * 1024 + k] : p.c_ctx[k]; sl[o] = cv / (1.0f + expf(-cv)); }
        __syncthreads();
        for (int item = blockIdx.x; item < 192; item += G) {
            const int l = item / 96, cq = lane & 15, rs = lane >> 4;
            f32x4 acc[9];
#pragma unroll
            for (int m = 0; m < 9; ++m) acc[m] = (f32x4){0.f, 0.f, 0.f, 0.f};
            const float* wa = p.w_ada + ((size_t)l * 1024 + wid * 128 + rs) * 6144 + (item % 96) * 64 + 4 * cq;
#pragma unroll 1
            for (int j0 = 0; j0 < 32; j0 += 16) {
                f32x4 wv[16];
#pragma unroll
                for (int jj = 0; jj < 16; ++jj) wv[jj] = __builtin_nontemporal_load((const f32x4*)(wa + (size_t)(4 * (j0 + jj)) * 6144));
#pragma unroll
                for (int jj = 0; jj < 16; ++jj)
#pragma unroll
                    for (int m = 0; m < 9; ++m) acc[m] = acc[m] + wv[jj] * sl[m * 1024 + wid * 128 + rs + 4 * (j0 + jj)];
            }
#pragma unroll
            for (int m = 0; m < 9; ++m) {
#pragma unroll
                for (int e = 0; e < 4; ++e) { float v = acc[m][e]; v += __shfl_xor(v, 16); v += __shfl_xor(v, 32); acc[m][e] = v; }
                if (rs == 0) *(LAS f32x4*)(red + (wid * 9 + m) * 64 + 4 * cq) = acc[m]; }
            __syncthreads();
            for (int o = tid; o < 9 * 64; o += NTHREADS) { const int m = o >> 6, cl = o & 63; float s = 0.f;
#pragma unroll
                for (int w = 0; w < 8; ++w) s += red[(w * 9 + m) * 64 + cl];
                const int cc = (item % 96) * 64 + cl; MOD[((size_t)l * 9 + m) * 6144 + cc] = s + p.b_ada[l * 6144 + cc]; }
            __syncthreads();
        }
    }
    LAS unsigned* scr = (LAS unsigned*)lds + wid * (64 * 66);
    const int NGW = G * NWAVES, NIT = TR_PRO_ITEMS;
    int it = blockIdx.x * NWAVES + wid;
    TrLane L; f32x4 a[8], b[8];
    if (it < NIT) { L = tr_lane(tr_decode_pro(p, it), lane); tr_load_l(L, a, b); }
    while (it < NIT) {
        const int itn = it + NGW; TrLane Ln = L; f32x4 an[8], bn[8];
        if (itn < NIT) { Ln = tr_lane(tr_decode_pro(p, itn), lane); tr_load_l(Ln, an, bn); }
        tr_process_l(L, a, b, scr, lane);
        L = Ln; it = itn;
#pragma unroll
        for (int q = 0; q < 8; ++q) { a[q] = an[q]; b[q] = bn[q]; }
    }
}

__device__ __forceinline__ float reduce16(const float (&acc)[16], int lane) {
    float v8[8], v4[4], v2[2];
    const bool b5 = lane & 32, b4 = lane & 16, b3 = lane & 8, b2 = lane & 4;
#pragma unroll
    for (int i = 0; i < 8; ++i) { const float keep = b5 ? acc[8 + i] : acc[i], send = b5 ? acc[i] : acc[8 + i]; v8[i] = keep + __shfl_xor(send, 32); }
#pragma unroll
    for (int i = 0; i < 4; ++i) { const float keep = b4 ? v8[4 + i] : v8[i], send = b4 ? v8[i] : v8[4 + i]; v4[i] = keep + __shfl_xor(send, 16); }
#pragma unroll
    for (int i = 0; i < 2; ++i) { const float keep = b3 ? v4[2 + i] : v4[i], send = b3 ? v4[i] : v4[2 + i]; v2[i] = keep + __shfl_xor(send, 8); }
    float v1 = (b2 ? v2[1] : v2[0]) + __shfl_xor(b2 ? v2[0] : v2[1], 4);
    v1 += __shfl_xor(v1, 2); v1 += __shfl_xor(v1, 1);
    return v1;
}
template <int MODE>
__device__ __forceinline__ void rowpass(const Params& p, int layer, LAS unsigned char* lds) {
    const int tid = opaque_tid(), lane = tid & 63, wid = __builtin_amdgcn_readfirstlane(tid >> 6), G = gridDim.x;
    unsigned char* ws = p.ws;
    LAS float* wsm = (LAS float*)lds;
    if (MODE != 3) {
        const float* src; size_t stride;
        if (MODE == 1) { src = p.w_router + (size_t)layer * 1024 * NE; stride = NE; }
        else { const int L = (MODE == 0) ? layer : layer + 1; src = p.w_in + (size_t)L * 1024 * INCOLS + 4352; stride = INCOLS; }
        for (int k = tid; k < 1024; k += NTHREADS) { const int slot = ((k >> 8) * 4 + (k & 3)) * 64 + ((k >> 2) & 63);
#pragma unroll
            for (int q = 0; q < 4; ++q) *(LAS f32x4*)(wsm + slot * 20 + 4 * q) = *(const f32x4*)(src + (size_t)k * stride + 4 * q); }
        __syncthreads();
    }
    constexpr int RP = 2;
    const bool latent_only = (MODE == 3) || (MODE == 1 && layer == 1);
    const int NR = latent_only ? NB * LAT : ROWS;
    const int modl = (MODE == 2) ? layer + 1 : layer;
    const float* MOD = (const float*)(ws + WS_MOD);
    bf16_t* XR = (bf16_t*)(ws + WS_XR); bf16_t* H = (bf16_t*)(ws + WS_H);
    const int NW = G * NWAVES;
    const float* nwp = ((MODE == 3) ? p.final_w : (MODE == 1) ? p.norm2_w + (size_t)layer * 1024 : p.norm1_w + (size_t)modl * 1024) + 4 * lane;
    for (int r0 = blockIdx.x * NWAVES + wid; r0 < NR; r0 += RP * NW) {
        int bb[RP], tt[RP], bms[RP]; size_t rows[RP]; bool valid[RP];
        f32x4 xv[RP][4];
#pragma unroll
        for (int r = 0; r < RP; ++r) {
            const int ri_ = r0 + r * NW; valid[r] = ri_ < NR; const int ri = valid[r] ? ri_ : r0;
            if (latent_only) { bb[r] = ri >> 11; tt[r] = CTXL + (ri & 2047); } else { bb[r] = ri / TOK; tt[r] = ri % TOK; }
            rows[r] = (size_t)bb[r] * TOK + tt[r]; bms[r] = (tt[r] < CTXL) ? 8 : bb[r];
            if (MODE == 0) {
                const float* src = (tt[r] < CTXL) ? p.ctx + ((size_t)bb[r] * CTXL + tt[r]) * 1024 : p.x + ((size_t)bb[r] * LAT + (tt[r] - CTXL)) * 1024;
#pragma unroll
                for (int j = 0; j < 4; ++j) xv[r][j] = *(const f32x4*)(src + 4 * lane + 256 * j);
            } else {
                const bf16_t* src = XR + rows[r] * 1024 + 4 * lane;
#pragma unroll
                for (int j = 0; j < 4; ++j) { const u32x2 w = *(const u32x2*)(src + 256 * j); xv[r][j] = (f32x4){bflo(w.x), bfhi(w.x), bflo(w.y), bfhi(w.y)}; }
            }
        }
        f32x4 nwv[4], shv[RP][4], scv[RP][4], g2v[RP][4];
#pragma unroll
        for (int j = 0; j < 4; ++j) nwv[j] = *(const f32x4*)(nwp + 256 * j);
#pragma unroll
        for (int r = 0; r < RP; ++r) {
            const float* md = MOD + ((size_t)modl * 9 + bms[r]) * 6144 + ((MODE == 1) ? 3072 : 0) + 4 * lane;
            const float* g2 = MOD + ((size_t)layer * 9 + bms[r]) * 6144 + 5120 + 4 * lane;
#pragma unroll
            for (int j = 0; j < 4; ++j) {
                if (MODE != 3) { shv[r][j] = *(const f32x4*)(md + 256 * j); scv[r][j] = *(const f32x4*)(md + 1024 + 256 * j); }
                if (MODE == 2 || MODE == 3) g2v[r][j] = *(const f32x4*)(g2 + 256 * j); }
        }
        if (MODE == 2 || MODE == 3) {
            const unsigned char* YE = ws + WS_YE;
            int slv[RP]; unsigned msk[RP]; f32x4 sum[RP][4];
#pragma unroll
            for (int r = 0; r < RP; ++r) { slv[r] = ((const int*)(ws + WS_SLOT))[rows[r] * NE + (lane & 15)]; msk[r] = (unsigned)__ballot(slv[r] >= 0) & 0xffffu;
#pragma unroll
                for (int j = 0; j < 4; ++j) sum[r][j] = (f32x4){0.f, 0.f, 0.f, 0.f}; }
            while (msk[0] | msk[RP - 1]) {
                unsigned w[RP][2][4]; float on[RP][2];
#pragma unroll
                for (int r = 0; r < RP; ++r)
#pragma unroll
                    for (int q = 0; q < 2; ++q) {
                        const bool has = msk[r] != 0u; const int e = has ? __builtin_ctz(msk[r]) : 0; msk[r] &= msk[r] - 1u; on[r][q] = has ? 1.f : 0.f;
                        int s = __builtin_amdgcn_readlane(slv[r], e); s = has ? s : 0;
                        const size_t yrow = (tt[r] < CTXL) ? (size_t)(e * 9 + 8) * 256 + bb[r] * 32 + s : (size_t)(e * 9 + bb[r]) * 256 + s; const unsigned char* yp = YE + yrow * 1024 + 4 * lane;
#pragma unroll
                        for (int j = 0; j < 4; ++j) w[r][q][j] = *(const unsigned*)(yp + 256 * j);
                    }
#pragma unroll
                for (int r = 0; r < RP; ++r)
#pragma unroll
                    for (int q = 0; q < 2; ++q)
#pragma unroll
                        for (int j = 0; j < 4; ++j) { const f32x2 lo = __builtin_amdgcn_cvt_pk_f32_fp8((int)w[r][q][j], false), hi = __builtin_amdgcn_cvt_pk_f32_fp8((int)w[r][q][j], true);
                            sum[r][j] = sum[r][j] + (f32x4){lo[0], lo[1], hi[0], hi[1]} * on[r][q]; }
            }
#pragma unroll
            for (int r = 0; r < RP; ++r) {
#pragma unroll
                for (int j = 0; j < 4; ++j) xv[r][j] = xv[r][j] + g2v[r][j] * (sum[r][j] * (1.0f / F8_YSCALE));
                if (MODE == 2 && valid[r]) {
#pragma unroll
                    for (int j = 0; j < 4; ++j) *(u32x2*)(XR + rows[r] * 1024 + 4 * lane + 256 * j) = (u32x2){cvtpk(xv[r][j][0], xv[r][j][1]), cvtpk(xv[r][j][2], xv[r][j][3])}; }
            }
        }
        float rinv[RP];
        { float ss[RP];
#pragma unroll
          for (int r = 0; r < RP; ++r) { ss[r] = 0.f;
#pragma unroll
              for (int j = 0; j < 4; ++j) ss[r] += (xv[r][j][0] * xv[r][j][0] + xv[r][j][1] * xv[r][j][1]) + (xv[r][j][2] * xv[r][j][2] + xv[r][j][3] * xv[r][j][3]); }
#pragma unroll
          for (int o = 1; o < 64; o <<= 1) {
#pragma unroll
              for (int r = 0; r < RP; ++r) ss[r] += __shfl_xor(ss[r], o); }
#pragma unroll
          for (int r = 0; r < RP; ++r) rinv[r] = rsqrtf(ss[r] * (1.0f / 1024.0f) + EPS); }
        if (MODE == 3) {
#pragma unroll
            for (int r = 0; r < RP; ++r) if (valid[r]) {
                float* o = p.out + ((size_t)bb[r] * LAT + (tt[r] - CTXL)) * 1024 + 4 * lane;
#pragma unroll
                for (int j = 0; j < 4; ++j) *(f32x4*)(o + 256 * j) = xv[r][j] * rinv[r] * nwv[j]; }
            continue;
        }
        f32x4 hv[RP][4];
#pragma unroll
        for (int r = 0; r < RP; ++r) {
#pragma unroll
            for (int j = 0; j < 4; ++j) { const f32x4 sh = shv[r][j], sc = scv[r][j];
                hv[r][j] = (xv[r][j] * rinv[r] * nwv[j]) * (sc + 1.0f) + sh;
                if (valid[r]) { if (MODE == 1) *(unsigned*)((unsigned char*)H + rows[r] * 1024 + 4 * lane + 256 * j) = cvt4_fp8(hv[r][j][0], hv[r][j][1], hv[r][j][2], hv[r][j][3]);
                                else { *(u32x2*)(H + rows[r] * 1024 + 4 * lane + 256 * j) = (u32x2){cvtpk(hv[r][j][0], hv[r][j][1]), cvtpk(hv[r][j][2], hv[r][j][3])};
                                       *(unsigned*)(ws + WS_H8IN + rows[r] * 1024 + 4 * lane + 256 * j) = cvt4_fp8(hv[r][j][0], hv[r][j][1], hv[r][j][2], hv[r][j][3]); } } }
        }
        float acc[RP][16];
#pragma unroll
        for (int r = 0; r < RP; ++r)
#pragma unroll
            for (int e = 0; e < 16; ++e) acc[r][e] = 0.f;
#pragma unroll
        for (int j = 0; j < 4; ++j)
#pragma unroll
            for (int i = 0; i < 4; ++i) { const LAS float* wp = wsm + ((4 * j + i) * 64 + lane) * 20;
#pragma unroll
                for (int q = 0; q < 4; ++q) { const f32x4 w = *(const LAS f32x4*)(wp + 4 * q);
#pragma unroll
                    for (int r = 0; r < RP; ++r) { const float h = hv[r][j][i]; acc[r][4 * q + 0] += h * w[0]; acc[r][4 * q + 1] += h * w[1]; acc[r][4 * q + 2] += h * w[2]; acc[r][4 * q + 3] += h * w[3]; } }
                __builtin_amdgcn_sched_barrier(0); }
        float red[RP];
#pragma unroll
        for (int r = 0; r < RP; ++r) red[r] = reduce16(acc[r], lane);
        int eidx = ((lane >> 5) & 1) * 8 + ((lane >> 4) & 1) * 4 + ((lane >> 3) & 1) * 2 + ((lane >> 2) & 1);
        asm volatile("" : "+v"(eidx));
#pragma unroll
        for (int r = 0; r < RP; ++r) {
            if (MODE == 1) {
                float mx = red[r];
#pragma unroll
                for (int o = 4; o < 64; o <<= 1) mx = fmaxf(mx, __shfl_xor(mx, o));
                const float ex = expf(red[r] - mx); float sum = ex;
#pragma unroll
                for (int o = 4; o < 64; o <<= 1) sum += __shfl_xor(sum, o);
                if (valid[r] && (lane & 3) == 0) ((float*)(ws + WS_AFF))[((size_t)bb[r] * NE + eidx) * TOK + tt[r]] = ex / sum;
            } else {
                if (valid[r] && (lane & 3) == 0) ((float*)(ws + WS_GATES))[rows[r] * 16 + eidx] = red[r];
            }
        }
    }
}

namespace ml {
constexpr int QP = 136, VP = 136;
constexpr int O_Q = 0, O_K = 34816, O_V = 69632, O_C = 104448, O_F = 139264;
constexpr int FSET = 656, F_AG = 0, F_BQ = 128, F_WI = 256, F_EM = 384, F_WW = 512, F_SC = 640, F_NV = 2 * FSET, F_NP = 2 * FSET + 128;
__device__ __forceinline__ s16x4 trr(const LAS bf16_t* p) { return __builtin_bit_cast(s16x4, __builtin_amdgcn_ds_read_tr16_b64_v4i16((LAS s16x4*)p)); }
__device__ __forceinline__ bf16x8 cat8(s16x4 a, s16x4 b) { return (bf16x8){a[0], a[1], a[2], a[3], b[0], b[1], b[2], b[3]}; }
__device__ __forceinline__ float fast_exp(float x) { return __builtin_amdgcn_exp2f(x * 1.4426950408889634f); }

#define ML_CHUNK(ci, L_, c_, rowb_) const bool isctx_ = (ci) < 2; const int L_ = isctx_ ? CTXL : LAT, c_ = isctx_ ? (ci) : (ci) - 2; const size_t rowb_ = (size_t)b * TOK + (isctx_ ? 0 : CTXL)

__device__ __forceinline__ void mlstm_item(const Params& p, int layer, int item, LAS unsigned char* lds) {
    const int tid = opaque_tid(), lane = tid & 63, wid = __builtin_amdgcn_readfirstlane(tid >> 6);
    const int b = item >> 3, head = (item >> 1) & 3, dir = item & 1;
    LAS bf16_t* Qs = (LAS bf16_t*)(lds + O_Q); LAS bf16_t* Ks = (LAS bf16_t*)(lds + O_K);
    LAS bf16_t* Vs = (LAS bf16_t*)(lds + O_V); LAS bf16_t* Cs = (LAS bf16_t*)(lds + O_C); LAS float* F = (LAS float*)(lds + O_F);
    const bf16_t* P = (const bf16_t*)(p.ws + WS_P); const float* GATES = (const float*)(p.ws + WS_GATES); bf16_t* HF = (bf16_t*)(p.ws + WS_HF);
    for (int i = tid; i < 128 * QP / 2; i += NTHREADS) ((LAS unsigned*)Cs)[i] = 0u;
    if (tid < 128) F[F_NV + tid] = 0.f;
    f32x16 Cacc[2];
#pragma unroll
    for (int r = 0; r < 16; ++r) { Cacc[0][r] = 0.f; Cacc[1][r] = 0.f; }
    const float gbi = p.gate_b[layer * 16 + dir * 8 + head], gbf = p.gate_b[layer * 16 + dir * 8 + 4 + head];
    float m_state = 0.f, gi0 = 0.f, gi1 = 0.f, gf0 = 0.f, gf1 = 0.f;
#define ML_LOAD_GATES(ci) do { ML_CHUNK(ci, Lg, cg_, rbg); \
        int g0_ = cg_ * 128 + 2 * lane; int t0_ = dir ? (Lg - 1 - g0_) : g0_, t1_ = dir ? (Lg - 2 - g0_) : (g0_ + 1); asm volatile("" : "+v"(t0_), "+v"(t1_)); \
        const float* ga_ = GATES + (rbg + t0_) * 16; const float* gb_ = GATES + (rbg + t1_) * 16; \
        gi0 = ga_[dir * 8 + head]; gf0 = ga_[dir * 8 + 4 + head]; gi1 = gb_[dir * 8 + head]; gf1 = gb_[dir * 8 + 4 + head]; } while (0)
#define ML_SCAN(st) do { LAS float* Fs = F + (st) * FSET; \
        const float fp0 = gf0 + gbf, fp1 = gf1 + gbf; \
        const float l0 = fminf(fp0, 0.f) - log1pf(expf(-fabsf(fp0))), l1 = fminf(fp1, 0.f) - log1pf(expf(-fabsf(fp1))); \
        const float s_ = l0 + l1; float incl = s_; \
        _Pragma("unroll") for (int o = 1; o < 64; o <<= 1) { const float tt = __shfl_up(incl, o); if (lane >= o) incl += tt; } \
        const float b0 = (incl - s_) + l0, b1 = incl; \
        const float a0 = (gi0 + gbi) - b0, a1 = (gi1 + gbi) - b1; \
        float inclm = fmaxf(a0, a1); \
        _Pragma("unroll") for (int o = 1; o < 64; o <<= 1) { const float tt = __shfl_up(inclm, o); if (lane >= o) inclm = fmaxf(inclm, tt); } \
        float exclm = __shfl_up(inclm, 1); if (lane == 0) exclm = -3.0e38f; \
        const float am0 = fmaxf(exclm, a0), am1 = inclm; \
        const float mt0 = b0 + fmaxf(m_state, am0), mt1 = b1 + fmaxf(m_state, am1); \
        const float blast = __shfl(b1, 63), amax = __shfl(inclm, 63); const float mnew_ = blast + fmaxf(m_state, amax); \
        *(LAS f32x2*)(Fs + F_AG + 2 * lane) = (f32x2){a0, a1}; *(LAS f32x2*)(Fs + F_BQ + 2 * lane) = (f32x2){b0 - mt0, b1 - mt1}; \
        *(LAS f32x2*)(Fs + F_WI + 2 * lane) = (f32x2){fast_exp(b0 + m_state - mt0), fast_exp(b1 + m_state - mt1)}; \
        *(LAS f32x2*)(Fs + F_EM + 2 * lane) = (f32x2){fast_exp(-mt0), fast_exp(-mt1)}; \
        *(LAS f32x2*)(Fs + F_WW + 2 * lane) = (f32x2){fast_exp(blast + a0 - mnew_), fast_exp(blast + a1 - mnew_)}; \
        if (lane == 0) { Fs[F_SC] = mnew_; Fs[F_SC + 1] = fast_exp(blast + m_state - mnew_); } \
        m_state = mnew_; } while (0)
#define ML_LOADS(ci) u32x4 xq[10]; unsigned hmask = 0u; do { ML_CHUNK(ci, Ll, cl, rbl); int g0_ = cl * 128 + 8 * rg - 1; asm volatile("" : "+v"(g0_)); \
        _Pragma("unroll") for (int i = 0; i < 10; ++i) { const int g_ = g0_ + i; const bool ok_ = g_ >= 0 && g_ < Ll; const int gc_ = ok_ ? g_ : g0_ + 1; \
            const int tk_ = dir ? (Ll - 1 - gc_) : gc_; hmask |= ok_ ? (1u << i) : 0u; xq[i] = *(const u32x4*)(P + (rbl + tk_) * NPROJ + qkcol); } } while (0)
    if (wid == 0) { ML_LOAD_GATES(0); }
    __syncthreads();
    for (int ci = 0; ci < 18; ++ci) {
        ML_CHUNK(ci, L, c, rowb);
        LAS float* Fc = F + (ci & 1) * FSET;
        int tid_o = tid; asm volatile("" : "+v"(tid_o));
        const int lane_o = tid_o & 63, r32 = lane_o & 31, hi = lane_o >> 5; const int lane = lane_o;
        const int cg = tid_o & 31, rg = tid_o >> 5; const bool isk = cg >= 16; const int chq = 8 * (cg & 15);
        const int qkcol = (isk ? PC_CK : PC_CQ) + head * 128 + chq; const float* cwp = p.conv_w + (size_t)layer * 3 * 1024 + (isk ? 512 : 0) + head * 128 + chq;
        const int tauv = tid_o >> 2, dgv = tid_o & 3;
#define ML_TOK(tau) (dir ? (L - 1 - (c * 128 + (tau))) : (c * 128 + (tau)))
        ML_LOADS(ci);
        if (wid == 0) { ML_SCAN(ci & 1); if (ci + 1 < 18) { ML_LOAD_GATES(ci + 1); } }
        {
            u32x4 xv[4];
            { int gv_ = c * 128 + tauv; asm volatile("" : "+v"(gv_)); const int tkv_ = dir ? (L - 1 - gv_) : gv_; const bf16_t* vs_ = P + (rowb + tkv_) * NPROJ + PC_CV + head * 128 + dgv * 32;
#pragma unroll
              for (int q = 0; q < 4; ++q) xv[q] = *(const u32x4*)(vs_ + 8 * q); }
#define ML_UNPACK(dst, i) do { const bool ok_ = (hmask >> (i)) & 1u; const u32x4 w_ = xq[i]; \
                dst[0] = ok_ ? bflo(w_.x) : 0.f; dst[1] = ok_ ? bfhi(w_.x) : 0.f; dst[2] = ok_ ? bflo(w_.y) : 0.f; dst[3] = ok_ ? bfhi(w_.y) : 0.f; \
                dst[4] = ok_ ? bflo(w_.z) : 0.f; dst[5] = ok_ ? bfhi(w_.z) : 0.f; dst[6] = ok_ ? bflo(w_.w) : 0.f; dst[7] = ok_ ? bfhi(w_.w) : 0.f; } while (0)
            float wlo[8], wmd[8], whi[8];
            { int wo_ = dir ? 2048 : 0; asm volatile("" : "+v"(wo_));
              const f32x4 a0_ = *(const f32x4*)(cwp + wo_), a1_ = *(const f32x4*)(cwp + wo_ + 4), m0_ = *(const f32x4*)(cwp + 1024), m1_ = *(const f32x4*)(cwp + 1028), c0_ = *(const f32x4*)(cwp + 2048 - wo_), c1_ = *(const f32x4*)(cwp + 2052 - wo_);
#pragma unroll
              for (int e = 0; e < 4; ++e) { wlo[e] = a0_[e]; wlo[4 + e] = a1_[e]; wmd[e] = m0_[e]; wmd[4 + e] = m1_[e]; whi[e] = c0_[e]; whi[4 + e] = c1_[e]; } }
            float xa[8], xb[8], xc[8];
            ML_UNPACK(xa, 0); ML_UNPACK(xb, 1);
            LAS bf16_t* dstb = (isk ? Ks : Qs) + (8 * rg) * QP + chq; const float osc = isk ? 0.08838834764831845f : 1.0f;
#pragma unroll
            for (int r = 0; r < 8; ++r) { float o[8];
                ML_UNPACK(xc, r + 2);
#pragma unroll
                for (int e = 0; e < 8; ++e) o[e] = fast_silu(wlo[e] * xa[e] + wmd[e] * xb[e] + whi[e] * xc[e]) * osc;
                *(LAS u32x4*)(dstb + r * QP) = (u32x4){cvtpk(o[0], o[1]), cvtpk(o[2], o[3]), cvtpk(o[4], o[5]), cvtpk(o[6], o[7])};
#pragma unroll
                for (int e = 0; e < 8; ++e) { xa[e] = xb[e]; xb[e] = xc[e]; } }
#undef ML_UNPACK
#pragma unroll
            for (int q = 0; q < 4; ++q) *(LAS u32x4*)(Vs + tauv * VP + dgv * 32 + 8 * q) = xv[q];
        }
        __syncthreads();
        const float decay = Fc[F_SC + 1];
        const int tb = wid >> 1, vpr = wid & 1; const int t_abs = 32 * tb + r32;
        int qoff = t_abs * QP + 8 * hi;
#define ML_QF(ks) (*(const LAS bf16x8*)(Qs + qoff + 16 * (ks)))
        f32x16 acc[2];
#pragma unroll
        for (int r = 0; r < 16; ++r) { acc[0][r] = 0.f; acc[1][r] = 0.f; }
#pragma unroll
        for (int ks = 0; ks < 8; ++ks)
#pragma unroll
            for (int u = 0; u < 2; ++u) { const bf16x8 cf = *(const LAS bf16x8*)(Cs + (32 * (2 * vpr + u) + r32) * QP + 16 * ks + 8 * hi); acc[u] = __builtin_amdgcn_mfma_f32_32x32x16_bf16(cf, ML_QF(ks), acc[u], 0, 0, 0); }
        const float wi_t = Fc[F_WI + t_abs], bq_t = Fc[F_BQ + t_abs];
#pragma unroll
        for (int r = 0; r < 16; ++r) { acc[0][r] *= wi_t; acc[1][r] *= wi_t; }
        float dsum = 0.f;
        const int trl = ((lane_o & 15) >> 2), tcl = 16 * ((lane_o >> 4) & 1) + 4 * (lane_o & 3);
        for (int sb = 0; sb <= tb; ++sb) {
            f32x16 st;
#pragma unroll
            for (int r = 0; r < 16; ++r) st[r] = 0.f;
            asm volatile("" : "+v"(qoff));
#pragma unroll
            for (int ks = 0; ks < 8; ++ks) { const bf16x8 kf = *(const LAS bf16x8*)(Ks + (32 * sb + r32) * QP + 16 * ks + 8 * hi); st = __builtin_amdgcn_mfma_f32_32x32x16_bf16(kf, ML_QF(ks), st, 0, 0, 0); }
            float pv[16];
#pragma unroll
            for (int r = 0; r < 16; ++r) { const int s_abs = 32 * sb + (r & 3) + 8 * (r >> 2) + 4 * hi;
                const float dd = __builtin_amdgcn_exp2f((bq_t + Fc[F_AG + s_abs]) * 1.4426950408889634f);
                const float val = (s_abs <= t_abs) ? st[r] * dd : 0.f; dsum += val; pv[r] = val; }
#pragma unroll
            for (int ksp = 0; ksp < 2; ++ksp) {
                const u32x4 pw = {cvtpk(pv[8 * ksp], pv[8 * ksp + 1]), cvtpk(pv[8 * ksp + 2], pv[8 * ksp + 3]), cvtpk(pv[8 * ksp + 4], pv[8 * ksp + 5]), cvtpk(pv[8 * ksp + 6], pv[8 * ksp + 7])};
#pragma unroll
                for (int u = 0; u < 2; ++u) {
                    const LAS bf16_t* va = Vs + (32 * sb + 16 * ksp + 4 * hi + trl) * VP + 32 * (2 * vpr + u) + tcl;
                    const bf16x8 vf = cat8(trr(va), trr(va + 8 * VP));
                    acc[u] = __builtin_amdgcn_mfma_f32_32x32x16_bf16(vf, __builtin_bit_cast(bf16x8, pw), acc[u], 0, 0, 0);
                }
            }
        }
        dsum += __shfl_xor(dsum, 32);
        float dq = 0.f;
#pragma unroll
        for (int c8 = 0; c8 < 8; ++c8) { const u32x4 qv = *(const LAS u32x4*)(Qs + t_abs * QP + 64 * hi + 8 * c8); const LAS float* nv = F + F_NV + 64 * hi + 8 * c8;
            dq += bflo(qv.x) * nv[0] + bfhi(qv.x) * nv[1] + bflo(qv.y) * nv[2] + bfhi(qv.y) * nv[3] + bflo(qv.z) * nv[4] + bfhi(qv.z) * nv[5] + bflo(qv.w) * nv[6] + bfhi(qv.w) * nv[7]; }
        dq += __shfl_xor(dq, 32);
        { const float den = dsum + wi_t * dq; const float inv = 1.0f / fmaxf(fabsf(den), Fc[F_EM + t_abs]);
          const int tok = ML_TOK(t_abs);
#pragma unroll
          for (int u = 0; u < 2; ++u) {
              bf16_t* o = HF + ((size_t)dir * ROWS + rowb + tok) * 512 + head * 128 + 32 * (2 * vpr + u) + 4 * hi;
#pragma unroll
              for (int g = 0; g < 4; ++g) *(u32x2*)(o + 8 * g) = (u32x2){cvtpk(acc[u][4 * g] * inv, acc[u][4 * g + 1] * inv), cvtpk(acc[u][4 * g + 2] * inv, acc[u][4 * g + 3] * inv)}; } }
        { const int vp2 = wid & 1, db = wid >> 1;
#pragma unroll
          for (int r = 0; r < 16; ++r) { Cacc[0][r] *= decay; Cacc[1][r] *= decay; }
#pragma unroll
          for (int ks = 0; ks < 8; ++ks) { const int R0 = 16 * ks + 8 * hi + trl;
              const LAS bf16_t* ka = Ks + R0 * QP + 32 * db + tcl;
              const s16x4 k0 = trr(ka), k1 = trr(ka + 4 * QP);
              const f32x4 w0 = *(const LAS f32x4*)(Fc + F_WW + 16 * ks + 8 * hi), w1 = *(const LAS f32x4*)(Fc + F_WW + 16 * ks + 8 * hi + 4);
              const u32x4 kw = {cvtpk(bf2f((unsigned short)k0[0]) * w0[0], bf2f((unsigned short)k0[1]) * w0[1]), cvtpk(bf2f((unsigned short)k0[2]) * w0[2], bf2f((unsigned short)k0[3]) * w0[3]),
                                cvtpk(bf2f((unsigned short)k1[0]) * w1[0], bf2f((unsigned short)k1[1]) * w1[1]), cvtpk(bf2f((unsigned short)k1[2]) * w1[2], bf2f((unsigned short)k1[3]) * w1[3])};
#pragma unroll
              for (int u = 0; u < 2; ++u) { const LAS bf16_t* va = Vs + R0 * VP + 32 * (2 * vp2 + u) + tcl;
                  const bf16x8 af = cat8(trr(va), trr(va + 4 * VP));
                  Cacc[u] = __builtin_amdgcn_mfma_f32_32x32x16_bf16(af, __builtin_bit_cast(bf16x8, kw), Cacc[u], 0, 0, 0); } }
          { float sp = 0.f; const int dd = tid_o & 127, part = tid_o >> 7;
#pragma unroll 8
            for (int s_ = 0; s_ < 32; ++s_) sp += Fc[F_WW + part * 32 + s_] * bf2f(Ks[(part * 32 + s_) * QP + dd]);
            F[F_NP + tid_o] = sp; }
          __syncthreads();
          float nnew = 0.f;
          if (tid_o < 128) nnew = decay * F[F_NV + tid_o] + ((F[F_NP + tid_o] + F[F_NP + 128 + tid_o]) + (F[F_NP + 256 + tid_o] + F[F_NP + 384 + tid_o]));
#pragma unroll
          for (int u = 0; u < 2; ++u)
#pragma unroll
              for (int r = 0; r < 16; ++r) { const int v = 32 * (2 * vp2 + u) + (r & 3) + 8 * (r >> 2) + 4 * hi; Cs[v * QP + 32 * db + r32] = (bf16_t)(cvtpk(Cacc[u][r], 0.f) & 0xffffu); }
          if (tid_o < 128) F[F_NV + tid_o] = nnew;
        }
#undef ML_TOK
#undef ML_QF
    }
    __syncthreads();
#undef ML_LOADS
#undef ML_SCAN
#undef ML_LOAD_GATES
}
#undef ML_CHUNK
}

__device__ __forceinline__ void postmix(const Params& p, int layer) {
    const int tid = opaque_tid(), lane = tid & 63, wid = __builtin_amdgcn_readfirstlane(tid >> 6), G = gridDim.x;
    unsigned char* ws = p.ws;
    const float* lv = p.dlam + (size_t)layer * 256;
    const float d01 = wave_sum(lv[lane] * lv[64 + lane]), d23 = wave_sum(lv[128 + lane] * lv[192 + lane]);
    const float lam_init = 0.8f - 0.6f * expf(-0.3f * (float)layer); const float lam = expf(d01) - expf(d23) + lam_init;
    const bf16_t* OAP = (const bf16_t*)(ws + WS_OAP); const bf16_t* HF = (const bf16_t*)(ws + WS_HF); const bf16_t* P = (const bf16_t*)(ws + WS_P); bf16_t* OABC = (bf16_t*)(ws + WS_OABC);
    const f32x2 sw = *(const f32x2*)(p.subln_w + (size_t)layer * 128 + 2 * lane);
    f32x2 mw[4];
#pragma unroll
    for (int h = 0; h < 4; ++h) mw[h] = *(const f32x2*)(p.mnorm_w + (size_t)layer * 512 + h * 128 + 2 * lane);
    const bool latent_only = layer == 1; const int NR = latent_only ? NB * LAT : ROWS;
    constexpr int RP = 2; const int NW = G * NWAVES;
    for (int r0 = blockIdx.x * NWAVES + wid; r0 < NR; r0 += RP * NW) {
        size_t rows[RP]; bool valid[RP];
        unsigned w0[RP][4], w1[RP][4], so[RP][4], h0[RP][4], h1[RP][4];
#pragma unroll
        for (int r = 0; r < RP; ++r) {
            const int ri_ = r0 + r * NW; valid[r] = ri_ < NR; const int ri = valid[r] ? ri_ : r0;
            rows[r] = latent_only ? (size_t)(ri >> 11) * TOK + CTXL + (ri & 2047) : (size_t)ri;
#pragma unroll
            for (int h = 0; h < 4; ++h) { const int cidx = h * 128 + 2 * lane;
                w0[r][h] = *(const unsigned*)(OAP + rows[r] * 1024 + h * 256 + 2 * lane); w1[r][h] = *(const unsigned*)(OAP + rows[r] * 1024 + h * 256 + 128 + 2 * lane);
                h0[r][h] = *(const unsigned*)(HF + rows[r] * 512 + cidx); h1[r][h] = *(const unsigned*)(HF + ((size_t)ROWS + rows[r]) * 512 + cidx);
                so[r][h] = *(const unsigned*)(P + rows[r] * NPROJ + PC_CO + cidx); }
        }
        float da[RP][4], db[RP][4], ha[RP][4], hb[RP][4], sa[RP][4], sc[RP][4];
#pragma unroll
        for (int r = 0; r < RP; ++r)
#pragma unroll
            for (int h = 0; h < 4; ++h) {
                da[r][h] = bflo(w0[r][h]) - lam * bflo(w1[r][h]); db[r][h] = bfhi(w0[r][h]) - lam * bfhi(w1[r][h]); sa[r][h] = da[r][h] * da[r][h] + db[r][h] * db[r][h];
                ha[r][h] = bflo(h0[r][h]) + bflo(h1[r][h]); hb[r][h] = bfhi(h0[r][h]) + bfhi(h1[r][h]); sc[r][h] = ha[r][h] * ha[r][h] + hb[r][h] * hb[r][h]; }
#pragma unroll
        for (int o = 1; o < 64; o <<= 1)
#pragma unroll
            for (int r = 0; r < RP; ++r)
#pragma unroll
                for (int h = 0; h < 4; ++h) { sa[r][h] += __shfl_xor(sa[r][h], o); sc[r][h] += __shfl_xor(sc[r][h], o); }
#pragma unroll
        for (int r = 0; r < RP; ++r) if (valid[r]) {
#pragma unroll
            for (int h = 0; h < 4; ++h) {
                const float ra = rsqrtf(sa[r][h] * (1.0f / 128.0f) + EPS) * (1.0f - lam_init), rc = rsqrtf(sc[r][h] * (1.0f / 128.0f) + EPS);
                *(unsigned*)(OABC + rows[r] * 1536 + h * 128 + 2 * lane) = cvtpk(da[r][h] * ra * sw[0], db[r][h] * ra * sw[1]);
                *(unsigned*)(OABC + rows[r] * 1536 + 1024 + h * 128 + 2 * lane) = cvtpk(ha[r][h] * rc * mw[h][0] * bflo(so[r][h]), hb[r][h] * rc * mw[h][1] * bfhi(so[r][h]));
            }
        }
    }
}

__device__ __forceinline__ void topk_item(const Params& p, int item, LAS unsigned char* lds) {
    const int tid = opaque_tid(), lane = tid & 63, wid = __builtin_amdgcn_readfirstlane(tid >> 6);
    unsigned char* ws = p.ws;
    const bool isctx = item >= 128; const int be = item & 127, b = be >> 4, e = be & 15;
    const int N = isctx ? CTXL : LAT, cap = isctx ? 32 : 256;
    const float* a = (const float*)(ws + WS_AFF) + ((size_t)b * NE + e) * TOK + (isctx ? 0 : CTXL);
    const size_t rowbase = (size_t)b * TOK + (isctx ? 0 : CTXL);
    const size_t xrow0 = isctx ? (size_t)(e * 9 + 8) * 256 + b * 32 : (size_t)(e * 9 + b) * 256;
    LAS unsigned* cntw = (LAS unsigned*)lds;
    LAS unsigned* segs = (LAS unsigned*)lds + 64;
    unsigned key[4]; float val[4];
#pragma unroll
    for (int it = 0; it < 4; ++it) { const int n = it * NTHREADS + tid; val[it] = (n < N) ? a[n] : 0.f; key[it] = (n < N) ? __float_as_uint(val[it]) : 0u; }
    unsigned T = 0u;
    for (int pos = 30; pos >= 0; pos -= 2) {
        unsigned cnt[3];
#pragma unroll
        for (int d = 0; d < 3; ++d) { const unsigned trial = T | ((unsigned)(d + 1) << pos); cnt[d] = 0u;
#pragma unroll
            for (int it = 0; it < 4; ++it) cnt[d] += (unsigned)__builtin_popcountll(__ballot(key[it] >= trial)); }
        LAS unsigned* cw = cntw + ((pos >> 1) & 1) * 32;
        if (lane == 0) { cw[wid * 4] = cnt[0]; cw[wid * 4 + 1] = cnt[1]; cw[wid * 4 + 2] = cnt[2]; }
        __syncthreads();
        unsigned tot[3] = {0u, 0u, 0u};
#pragma unroll
        for (int w = 0; w < 8; ++w) { tot[0] += cw[w * 4]; tot[1] += cw[w * 4 + 1]; tot[2] += cw[w * 4 + 2]; }
        const unsigned dsel = (tot[2] >= (unsigned)cap) ? 3u : (tot[1] >= (unsigned)cap) ? 2u : (tot[0] >= (unsigned)cap) ? 1u : 0u;
        T |= dsel << pos;
    }
    const unsigned long long ltmask = (1ull << lane) - 1ull;
    unsigned pg[4], pe[4];
#pragma unroll
    for (int it = 0; it < 4; ++it) { const unsigned long long bg = __ballot(key[it] > T), bq = __ballot(key[it] == T);
        pg[it] = (unsigned)__builtin_popcountll(bg & ltmask); pe[it] = (unsigned)__builtin_popcountll(bq & ltmask);
        if (lane == 0) { segs[it * 8 + wid] = (unsigned)__builtin_popcountll(bg); segs[32 + it * 8 + wid] = (unsigned)__builtin_popcountll(bq); } }
    __syncthreads();
    unsigned totg = 0u;
    for (int s = 0; s < 32; ++s) totg += segs[s];
    const unsigned need = (unsigned)cap - totg;
    int* SLOT = (int*)(ws + WS_SLOT); float* GSEL = (float*)(ws + WS_GSEL); int* XIDX = (int*)(ws + WS_XIDX);
#pragma unroll
    for (int it = 0; it < 4; ++it) { const int n = it * NTHREADS + tid; const int seg = it * 8 + wid;
        unsigned prg = 0u, pre = 0u;
        for (int s = 0; s < seg; ++s) { prg += segs[s]; pre += segs[32 + s]; }
        if (n < N) { const unsigned rank_eq = pre + pe[it]; const bool sel = (key[it] > T) || (key[it] == T && rank_eq < need);
            int slot = -1;
            if (sel) { const unsigned eqb = rank_eq < need ? rank_eq : need; slot = (int)(prg + pg[it] + eqb); XIDX[xrow0 + slot] = (int)rowbase + n; GSEL[xrow0 + slot] = val[it]; }
            SLOT[(rowbase + n) * NE + e] = slot; } }
    __syncthreads();
}
#define XB_TMO      128
#define XB_XCNT(j)  (256  + 64 * (j))
#define XB_XSUB(j)  (1280 + 64 * (j))
#define XB_XGEN(j)  (2304 + 64 * (j))
#define XB_TOP      3328
#define XB_TOPGEN   3392
#define XCD_BAR_WORDS 3456
#define XB_SPIN_CAP (1u << 18)

__device__ __forceinline__ unsigned xb_ld(unsigned* p)              { return __hip_atomic_load(p, __ATOMIC_RELAXED, __HIP_MEMORY_SCOPE_AGENT); }
__device__ __forceinline__ unsigned xb_add(unsigned* p, unsigned v) { return __hip_atomic_fetch_add(p, v, __ATOMIC_RELAXED, __HIP_MEMORY_SCOPE_AGENT); }
__device__ __forceinline__ unsigned xb_xcc_id() { return (unsigned)__builtin_amdgcn_s_getreg((3 << 11) | 20) & 0xFu; }
#define XB_SPIN(cond, bar) do { unsigned _sp = 0; while (cond) { __builtin_amdgcn_s_sleep(1); \
    if ((++_sp & 255u) == 0u) { if (xb_ld(&(bar)[XB_TMO])) break; if (_sp > XB_SPIN_CAP) { atomicAdd(&(bar)[XB_TMO], 1u); break; } } } } while (0)

struct XcdBarrier {
    unsigned* bar; unsigned x;
    volatile LAS unsigned* st;
};

__device__ __forceinline__ XcdBarrier xcd_barrier_post(unsigned* bar, volatile LAS unsigned* st) {
    XcdBarrier b; b.bar = bar; b.x = xb_xcc_id(); b.st = st;
    if (threadIdx.x == 0) (void)xb_add(&bar[XB_XCNT(b.x)], 1u);
    return b;
}
__device__ __forceinline__ void xcd_barrier_complete(unsigned* bar, unsigned x, unsigned& nloc, unsigned& nx) {
    const unsigned G = gridDim.x * gridDim.y * gridDim.z;
    unsigned sum, cnt, mine, sp = 0u;
    for (;;) {
        sum = 0u; cnt = 0u; mine = 0u;
#pragma unroll
        for (unsigned j = 0; j < 16; ++j) { const unsigned c = xb_ld(&bar[XB_XCNT(j)]); sum += c; cnt += (c > 0u) ? 1u : 0u; mine = (j == x) ? c : mine; }
        if (sum == G) break;
        __builtin_amdgcn_s_sleep(1);
        if ((++sp & 255u) == 0u) { if (xb_ld(&bar[XB_TMO])) break; if (sp > XB_SPIN_CAP) { atomicAdd(&bar[XB_TMO], 1u); break; } }
    }
    nloc = mine > 0u ? mine : 1u; nx = cnt > 0u ? cnt : 1u;
}

__device__ __forceinline__ void xcd_barrier(const XcdBarrier& b) {
    asm volatile("s_waitcnt vmcnt(0)" ::: "memory");
    __syncthreads();
    if (threadIdx.x == 0) {
        unsigned* bar = b.bar;
        __builtin_amdgcn_s_waitcnt(0);
        unsigned nloc = b.st[0], nx = b.st[1];
        if (nloc == 0u) { xcd_barrier_complete(bar, b.x, nloc, nx); b.st[0] = nloc; b.st[1] = nx; }
        const unsigned old = xb_add(&bar[XB_XSUB(b.x)], 1u);
        const unsigned gen = old / nloc;
        if (old + 1u == (gen + 1u) * nloc) {
            __builtin_amdgcn_fence(__ATOMIC_RELEASE, "agent");
            asm volatile("s_waitcnt vmcnt(0)" ::: "memory");
            const unsigned og = xb_add(&bar[XB_TOP], 1u);
            const unsigned tg = og / nx;
            if (og + 1u == (tg + 1u) * nx) xb_add(&bar[XB_TOPGEN], 1u);
            else XB_SPIN(xb_ld(&bar[XB_TOPGEN]) == tg, bar);
            __builtin_amdgcn_fence(__ATOMIC_ACQUIRE, "agent");
            xb_add(&bar[XB_XGEN(b.x)], 1u);
            asm volatile("s_waitcnt vmcnt(0)" ::: "memory");
        } else {
            XB_SPIN(xb_ld(&bar[XB_XGEN(b.x)]) == gen, bar);
            __builtin_amdgcn_fence(__ATOMIC_ACQUIRE, "agent");
            asm volatile("s_waitcnt vmcnt(0)" ::: "memory");
        }
    }
    __syncthreads();
}

#ifndef CONV_SPREAD
#define CONV_SPREAD 6
#endif
#ifndef DUPMASK
#define DUPMASK 0
#endif
__device__ __forceinline__ void attn_item(const Params& p, int layer, int it, LAS unsigned char* lds, char* lds_g) {
    using attn_body::bf16;
    const bf16* P = (const bf16*)(p.ws + WS_P);
    int a = it - (layer == 0 ? 170 : 160), b, vh, qrow, nt; bool isA;
    if (a < 1024) { isA = a < 512; a &= 511; b = a >> 6; vh = (a >> 3) & 7; qrow = CTXL + (a & 7) * 256; nt = TOK / 64; }
    else { a -= 1024; isA = a < 64; a &= 63; b = a >> 3; vh = a & 7; qrow = 0; nt = CTXL / 64; }
    const size_t krow = (size_t)b * TOK, row0 = krow + qrow;
    if (isA) { const int h = vh >> 1, j = vh & 1;
        attn_body::attn_unit128<8>(P + row0 * NPROJ + PC_AQ + h * 128 + j * 64, P + krow * NPROJ + PC_AK + h * 128 + j * 64, P + krow * NPROJ + PC_AV + h * 128,
                                   (bf16*)(p.ws + WS_OAP) + row0 * 1024 + h * 256 + j * 128, 1024, nt, lds_g); }
    else { const int hq = vh;
        attn_body::attn_unit<8>(P + row0 * NPROJ + PC_BQ + hq * 64, P + krow * NPROJ + PC_BK + (hq >> 2) * 64, P + krow * NPROJ + PC_BV + (hq >> 2) * 64,
                                (bf16*)(p.ws + WS_OABC) + row0 * 1536 + 512 + hq * 64, 1536, nt, lds_g); }
}

template <int PH>
__device__ __forceinline__ void run_phase(const Params& p, int layer, LAS unsigned char* lds, char* lds_g) {
    unsigned char* ws = p.ws; const int G = gridDim.x, bx = blockIdx.x;
    if constexpr (PH == 0) prologue(p, lds);
    if constexpr (PH == 1) rowpass<0>(p, layer, lds);
    if constexpr (PH == 2) {
        {
            pg8::Gemm g{(const bf16_t*)(ws + WS_H), (const bf16_t*)(ws + WS_WIN) + (size_t)layer * NPROJ * 1024, 1024, 1024, 1024};
            pg8::OrderInProj S; S.init(layer, G, bx);
            const float* cosT = (const float*)(ws + WS_ROPE);
            pg8::EpiInProj E{(bf16_t*)(ws + WS_P), cosT, cosT + LAT * 32, p.qnw + layer * 64, p.knw + layer * 64};
            pg8::gemm_phase(lds, g, S, E);
        }
        {
            pg8::Gemm g{(const bf16_t*)(ws + WS_H8IN), (const bf16_t*)(ws + WS_WG8 + (size_t)layer * 3072 * 1024), 512, 512, 512};
            pg8::OrderGates S; S.init(layer, G, bx);
            pg8::EpiGates E{(bf16_t*)(ws + WS_P)};
            pg8::gemm_phase<false, true>(lds, g, S, E);
        }
    }
    if constexpr (PH == 3) {
#ifndef CONVDUP
#define CONVDUP 1
#endif
        const int ncv1 = layer == 0 ? 106 : 96, ncv = ncv1 * CONVDUP, nit = 64 + ncv + 1024 + (layer == 0 ? 128 : 0);
        unsigned* head = (unsigned*)(ws + WS_CTL) + CW_QUEUE + 64 * layer;
        volatile LAS unsigned* slot = (volatile LAS unsigned*)(lds + DYN_LDS_BYTES - 32);
        for (;;) {
            if (threadIdx.x == 0) *slot = __hip_atomic_fetch_add(head, 1u, __ATOMIC_RELAXED, __HIP_MEMORY_SCOPE_AGENT);
            __syncthreads();
            const int it = (int)*slot;
            __syncthreads();
            if (it >= nit) break;
            const int pq = it - 64, gq = pq / CONV_SPREAD, rq = pq - gq * CONV_SPREAD;
            if (it < 64) { ml::mlstm_item(p, layer, it, lds); }
            else if (gq < ncv && rq == 0) { const int k = gq % ncv1; convert_item(p, lds, k < 96 ? layer * TR_BG_L0 + k * 256 : TR_BG_ITEMS + (k - 96) * 256); }
            else { const int ai = (gq < ncv) ? pq - (gq + 1) : pq - ncv; attn_item(p, layer, 64 + ncv1 + ai, lds, lds_g); }
        }
    }
    if constexpr (PH == 4) postmix(p, layer);
    if constexpr (PH == 5) {
        const int lo = layer == 1;
        pg8::Gemm g{(const bf16_t*)(ws + WS_OABC), (const bf16_t*)(ws + WS_WBR) + (size_t)layer * 1024 * 1536, 1536, 1536, 1536};
        pg8::Order<pg8::MapDense, 4> S; S.init(lo ? 64 : 72, 4, G, bx, pg8::MapDense{lo});
        pg8::EpiMerge E{(const bf16_t*)(ws + WS_P), (bf16_t*)(ws + WS_MERGED)};
        pg8::gemm_phase(lds, g, S, E);
    }
    if constexpr (PH == 6) {
        const int lo = layer == 1;
        pg8::Gemm g{(const bf16_t*)(ws + WS_MERGED), (const bf16_t*)(ws + WS_WOUT) + (size_t)layer * 1024 * 1024, 1024, 1024, 1024};
        pg8::Order<pg8::MapDense, 4> S; S.init(lo ? 64 : 72, 4, G, bx, pg8::MapDense{lo});
        pg8::EpiOut E{p.x, p.ctx, (bf16_t*)(ws + WS_XR), (const float*)(ws + WS_MOD) + (size_t)layer * 9 * 6144, layer};
        pg8::gemm_phase(lds, g, S, E);
    }
    if constexpr (PH == 7) rowpass<1>(p, layer, lds);
    if constexpr (PH == 8) { const int nit = layer == 0 ? 256 : 128; for (int it = bx; it < nit; it += G) topk_item(p, it, lds);
    }
    if constexpr (PH == 9) {
        const int T = layer == 0 ? 9 : 8;
        pg8::Gemm g{(const bf16_t*)(ws + WS_H), (const bf16_t*)(ws + WS_WGU + (size_t)layer * NE * 4096 * 1024), 512, 512, 512, (const int*)(ws + WS_XIDX)};
        pg8::Order<pg8::MapFFN, 16> S; S.init(NE * T, 16, G, bx, pg8::MapFFN{T, 4096});
        pg8::EpiGateUp E{ws + WS_ACT};
        pg8::gemm_phase<true, true>(lds, g, S, E);
    }
    if constexpr (PH == 10) {
        const int T = layer == 0 ? 9 : 8;
        pg8::Gemm g{(const bf16_t*)(ws + WS_ACT), (const bf16_t*)(ws + WS_WDN + (size_t)layer * NE * 1024 * 2048), 1024, 1024, 1024};
        pg8::Order<pg8::MapFFN, 4> S; S.init(NE * T, 4, G, bx, pg8::MapFFN{T, 1024});
        pg8::EpiDown E{ws + WS_YE, (const float*)(ws + WS_GSEL)};
        pg8::gemm_phase<false, true>(lds, g, S, E);
    }
    if constexpr (PH == 11) { if (layer == 0) rowpass<2>(p, layer, lds); else rowpass<3>(p, layer, lds); }
}

#ifndef MEGA
#define MEGA 1
#endif
#if MEGA
#define GRID_SYNC() xcd_barrier(bar)
#define RUN(PH, layer) do { _Pragma("unroll 1") for (int rep_ = 0; rep_ < 1 + ((DUPMASK >> PH) & 1); ++rep_) { run_phase<PH>(p, layer, lds, lds_g); GRID_SYNC(); } } while (0)
__global__ void __launch_bounds__(NTHREADS, 2) k_mega(Params p) {
    extern __shared__ __attribute__((aligned(16))) unsigned char lds_raw[];
    LAS unsigned char* lds = (LAS unsigned char*)lds_raw; char* lds_g = (char*)lds_raw;
    volatile LAS unsigned* bst = (volatile LAS unsigned*)(lds + DYN_LDS_BYTES - 64);
    if (threadIdx.x < 16) bst[threadIdx.x] = 0u;
    __syncthreads();
    const XcdBarrier bar = xcd_barrier_post((unsigned*)(p.ws + WS_CTL) + CW_BAR, bst);
    RUN(0, 0);
    RUN(1, 0);
#pragma unroll 1
    for (int layer = 0; layer < 2; ++layer) {
        RUN(2, layer);
        RUN(3, layer);
        RUN(4, layer);
        RUN(5, layer);
        RUN(6, layer);
        RUN(7, layer);
        RUN(8, layer);
        RUN(9, layer);
        RUN(10, layer);
        RUN(11, layer);
    }
}
#else
template <int PH> __global__ void __launch_bounds__(NTHREADS, 2) k_phase(Params p, int layer) {
    extern __shared__ __attribute__((aligned(16))) unsigned char lds_raw[];
    run_phase<PH>(p, layer, (LAS unsigned char*)lds_raw, (char*)lds_raw);
}
template <int PH> static void launch_phase(const Params& p, int layer, int grid, hipStream_t stream) {
    static bool attr = false;
    if (!attr) { (void)hipFuncSetAttribute((const void*)k_phase<PH>, hipFuncAttributeMaxDynamicSharedMemorySize, DYN_LDS_BYTES); attr = true; }
    hipLaunchKernelGGL(k_phase<PH>, dim3(grid), dim3(NTHREADS), DYN_LDS_BYTES, stream, p, layer);
}
#endif

extern "C" void kernel_launch(void* const* d_in, const int* in_sizes, int n_in, void* d_out, int out_size, void* d_ws, size_t ws_size, hipStream_t stream) {
    static int grid = 0;
    if (grid == 0) {
        if (n_in != 25 || ws_size < WS_END) { fprintf(stderr, "kernel_launch: expected 25 inputs and >= %zu bytes of workspace, got %d / %zu\n", (size_t)WS_END, n_in, ws_size); grid = -1; return; }
        int dev = 0, cus = 0; (void)hipGetDevice(&dev); (void)hipDeviceGetAttribute(&cus, hipDeviceAttributeMultiprocessorCount, dev);
        if (cus <= 0) cus = 256;
#if MEGA
        int per_cu = 0;
        if (hipFuncSetAttribute((const void*)k_mega, hipFuncAttributeMaxDynamicSharedMemorySize, DYN_LDS_BYTES) != hipSuccess) { fprintf(stderr, "kernel_launch: hipFuncSetAttribute failed\n"); grid = -1; return; }
        if (hipOccupancyMaxActiveBlocksPerMultiprocessor(&per_cu, (const void*)k_mega, NTHREADS, DYN_LDS_BYTES) != hipSuccess || per_cu < 1) { fprintf(stderr, "kernel_launch: occupancy query says %d blocks per CU\n", per_cu); (void)hipGetLastError(); per_cu = 1; }
        grid = cus * 1;
#else
        grid = cus;
#endif
    }
    if (grid < 0) return;
    Params p{};
    const float** pp = (const float**)&p;
    for (int i = 0; i < 25; ++i) pp[i] = (const float*)d_in[i];
    p.out = (float*)d_out; p.ws = (unsigned char*)d_ws;
    (void)hipMemsetAsync((char*)d_ws + WS_CTL, 0, CTL_BYTES, stream);
#if MEGA
    hipLaunchKernelGGL(k_mega, dim3(grid), dim3(NTHREADS), DYN_LDS_BYTES, stream, p);
#else
    launch_phase<0>(p, 0, grid, stream);
    launch_phase<1>(p, 0, grid, stream);
    for (int layer = 0; layer < 2; ++layer) {
        launch_phase<2>(p, layer, grid, stream);
        launch_phase<3>(p, layer, grid, stream);
        launch_phase<4>(p, layer, grid, stream);
        launch_phase<5>(p, layer, grid, stream);
        launch_phase<6>(p, layer, grid, stream);
        launch_phase<7>(p, layer, grid, stream);
        launch_phase<8>(p, layer, grid, stream);
        launch_phase<9>(p, layer, grid, stream);
        launch_phase<10>(p, layer, grid, stream);
        launch_phase<11>(p, layer, grid, stream);
    }
#endif
}
```
